# Optimizing an MI355X kernel written in HIP

```python
import jax, jax.numpy as jnp
from jax import lax
import numpy as np

D_MODEL = 1024
BATCH = 8
SEQ = 2048
DEPTH = 1
DEC_BATCH = 128
DEC_SEQ = 4
PAST_LEN = 16384
PAGE_SIZE = 128

POOL_WIDTH = D_MODEL // 4
POOL_WINDOWS = (2, 4, 8, 16)
POOL_GROUPS = len(POOL_WINDOWS)
POOL_GDIM = POOL_WIDTH // POOL_GROUPS
POOL_BUF = max(POOL_WINDOWS) - 1
HG_HEADS = 4
HG_KDIM = 128
HG_WIDTH = HG_HEADS * HG_KDIM
HG_VDIM = D_MODEL // 2 // HG_HEADS
HG_VWIDTH = HG_HEADS * HG_VDIM
HG_CHUNK = 64
MEM_LEN = 256
MEM_HEADS = 4
MEM_HDIM = D_MODEL // 4 // MEM_HEADS
MEM_WIDTH = MEM_HEADS * MEM_HDIM
N_BRANCH = 3
D_FF = 2816
CONV_W = 3

LN_EPS = 1e-5
RMS_EPS = 1e-6
DN_ALPHA = (2 * DEPTH) ** 0.25
DN_BETA = (8 * DEPTH) ** -0.25

SPLIT_SIZES = (POOL_WIDTH, HG_WIDTH, HG_WIDTH, HG_VWIDTH, HG_VWIDTH, MEM_WIDTH)
SPLIT_POINTS = tuple(int(s) for s in np.cumsum(SPLIT_SIZES))
IN_COLS = sum(SPLIT_SIZES) + N_BRANCH * D_MODEL

kernel_name = 'hybrid_pool_hgrn2_memxattn_convffn_step'


def layer_norm(x, g, b):
    xf = x.astype(jnp.float32)
    mu = jnp.mean(xf, axis=-1, keepdims=True)
    var = jnp.mean(jnp.square(xf - mu), axis=-1, keepdims=True)
    return ((xf - mu) * lax.rsqrt(var + LN_EPS) * g + b).astype(x.dtype)


def rms_norm(x, g):
    xf = x.astype(jnp.float32)
    return xf * lax.rsqrt(jnp.mean(jnp.square(xf), axis=-1, keepdims=True) + RMS_EPS) * g


def multiscale_pool(u, buf, pos0, w_grp, scale):
    bsz, seq_len, _ = u.shape
    full = jnp.concatenate([buf.astype(u.dtype), u], axis=1)
    csum = jnp.cumsum(full.astype(jnp.float32), axis=1)
    csum = jnp.concatenate([jnp.zeros((bsz, 1, POOL_WIDTH), jnp.float32), csum], axis=1)
    end = csum[:, POOL_BUF + 1:POOL_BUF + 1 + seq_len]
    pos = pos0 + jnp.arange(seq_len)
    pooled = []
    for g, w in enumerate(POOL_WINDOWS):
        sl = slice(g * POOL_GDIM, (g + 1) * POOL_GDIM)
        start = csum[:, POOL_BUF + 1 - w:POOL_BUF + 1 - w + seq_len, sl]
        count = jnp.minimum(pos + 1, w).astype(jnp.float32)[None, :, None]
        pooled.append((end[..., sl] - start) / count)
    diff = (jnp.concatenate(pooled, axis=-1) - u.astype(jnp.float32)).astype(u.dtype)
    diff = diff.reshape(bsz, seq_len, POOL_GROUPS, POOL_GDIM)
    mixed = jnp.einsum('blgc,gcd->blgd', diff, w_grp).reshape(bsz, seq_len, POOL_WIDTH) * scale
    return mixed, full[:, -POOL_BUF:]


def hgrn2_chunkwise(q, logf, k, v, s0):
    bsz, seq_len, n_heads, _ = q.shape
    dv = v.shape[-1]
    chunk = min(HG_CHUNK, seq_len)
    n_chunks = -(-seq_len // chunk)
    pad = n_chunks * chunk - seq_len

    def to_chunks(a):
        a = jnp.pad(a, ((0, 0), (0, pad), (0, 0), (0, 0)))
        return a.reshape(bsz, n_chunks, chunk, n_heads, a.shape[-1]).transpose(1, 0, 3, 2, 4)

    qc, lfc, kc, vc = to_chunks(q), to_chunks(logf), to_chunks(k), to_chunks(v)
    causal = jnp.tril(jnp.ones((chunk, chunk), bool))[:, :, None]

    def step(state, inp):
        qi, lfi, ki, vi = inp
        b = jnp.cumsum(lfi, axis=2)
        gap = b[:, :, :, None, :] - b[:, :, None, :, :]
        decay = jnp.exp(jnp.where(causal, gap, -jnp.inf))
        scores = jnp.einsum('bhtd,bhsd,bhtsd->bhts', qi, ki, decay)
        out = jnp.einsum('bhts,bhse->bhte', scores, vi) + jnp.einsum('bhtd,bhde->bhte', qi * jnp.exp(b), state)
        b_last = b[:, :, -1:, :]
        new_state = jnp.exp(b_last[:, :, 0, :, None]) * state + jnp.einsum('bhsd,bhse->bhde', ki * jnp.exp(b_last - b), vi)
        return new_state, out

    s_final, out = lax.scan(step, s0, (qc, lfc, kc, vc))
    out = out.transpose(1, 0, 3, 2, 4).reshape(bsz, n_chunks * chunk, n_heads, dv)[:, :seq_len]
    return out, s_final


def memory_attention(q, mem_k, mem_v):
    s = jnp.einsum('blhd,bmhd->bhlm', q, mem_k).astype(jnp.float32) * (MEM_HDIM ** -0.5)
    p = jax.nn.softmax(s, axis=-1).astype(mem_v.dtype)
    return jnp.einsum('bhlm,bmhd->blhd', p, mem_v)


def conv_ffn(h, buf, w_gate, w_up, conv_w, conv_b, w_down):
    seq_len = h.shape[1]
    a = h @ w_gate
    u = h @ w_up
    full = jnp.concatenate([buf.astype(a.dtype), a], axis=1)
    c = conv_b + full[:, 0:seq_len] * conv_w[0]
    for j in range(1, CONV_W):
        c = c + full[:, j:j + seq_len] * conv_w[j]
    act = jax.nn.gelu(c.astype(jnp.float32), approximate=False).astype(h.dtype)
    return (act * u) @ w_down, full[:, -(CONV_W - 1):]


def decoder_layer(x, pool_buf, hg_state, conv_buf, mem_k, mem_v, pos0, lb, p):
    bsz, seq_len, _ = x.shape
    dt = x.dtype
    u_a, q_b, f_b, i_b, g_b, q_c, gate_pre = jnp.split(x @ p['w_in'], SPLIT_POINTS, axis=-1)
    y_a, new_pool = multiscale_pool(u_a, pool_buf, pos0, p['w_pool_grp'], p['pool_scale'])
    f_pre = f_b.astype(jnp.float32)
    f = lb + (1.0 - lb) * jax.nn.sigmoid(f_pre)
    k = (1.0 - lb) * jax.nn.sigmoid(-f_pre)
    ks = (bsz, seq_len, HG_HEADS, HG_KDIM)
    vs = (bsz, seq_len, HG_HEADS, HG_VDIM)
    o_b, s_new = hgrn2_chunkwise(jax.nn.silu(q_b.astype(jnp.float32)).reshape(ks), jnp.log(f).reshape(ks),
                                 k.reshape(ks), i_b.astype(jnp.float32).reshape(vs), hg_state.astype(jnp.float32))
    o_b = rms_norm(o_b, p['hg_norm_g'].reshape(HG_HEADS, HG_VDIM)).reshape(bsz, seq_len, HG_VWIDTH)
    y_b = (o_b * jax.nn.silu(g_b.astype(jnp.float32))).astype(dt)
    y_c = memory_attention(q_c.reshape(bsz, seq_len, MEM_HEADS, MEM_HDIM), mem_k, mem_v).reshape(bsz, seq_len, MEM_WIDTH)
    gates = jax.nn.sigmoid(gate_pre.astype(jnp.float32)).astype(dt).reshape(bsz, seq_len, N_BRANCH, D_MODEL)
    merged = (gates[:, :, 0] * (y_a @ p['w_br_pool'])
              + gates[:, :, 1] * (y_b @ p['w_br_hg'])
              + gates[:, :, 2] * (y_c @ p['w_br_mem']))
    h = layer_norm(DN_ALPHA * x + merged @ p['w_out'], p['ln1_g'], p['ln1_b'])
    ff, new_conv = conv_ffn(h, conv_buf, p['w_gate'], p['w_up'], p['conv_w'], p['conv_b'], p['w_down'])
    y = layer_norm(DN_ALPHA * h + ff, p['ln2_g'], p['ln2_b'])
    return y, new_pool, s_new.astype(hg_state.dtype), new_conv


def setup_inputs(seed: int = 0) -> dict:
    key = jax.random.key(seed)
    ks = jax.random.split(key, 32)

    def nrm(k, shape, s):
        return jax.random.normal(k, shape, jnp.float32) * s

    return {
        'x_prompt': nrm(ks[0], (BATCH, SEQ, D_MODEL), 1.0),
        'x_sample': nrm(ks[1], (DEC_BATCH, DEC_SEQ, D_MODEL), 1.0),
        'state_pool': nrm(ks[2], (DEPTH, DEC_BATCH, POOL_BUF, POOL_WIDTH), 1.0),
        'state_hgrn': nrm(ks[3], (DEPTH, DEC_BATCH, HG_HEADS, HG_KDIM, HG_VDIM), 0.5),
        'state_ffn_conv': nrm(ks[4], (DEPTH, DEC_BATCH, CONV_W - 1, D_FF), 1.0),
        'cache_mem_k': nrm(ks[5], (DEPTH, DEC_BATCH, MEM_LEN, MEM_HEADS, MEM_HDIM), 1.0),
        'cache_mem_v': nrm(ks[6], (DEPTH, DEC_BATCH, MEM_LEN, MEM_HEADS, MEM_HDIM), 1.0),
        'mem_prompt': nrm(ks[7], (BATCH, MEM_LEN, D_MODEL), 1.0),
        'lb_logits': nrm(ks[8], (DEPTH + 1, HG_WIDTH), 0.1),
        'w_in': nrm(ks[9], (DEPTH, D_MODEL, IN_COLS), D_MODEL ** -0.5),
        'w_pool_grp': nrm(ks[10], (DEPTH, POOL_GROUPS, POOL_GDIM, POOL_GDIM), POOL_GDIM ** -0.5),
        'pool_scale': 1.0 + nrm(ks[11], (DEPTH, POOL_WIDTH), 0.02),
        'hg_norm_g': 1.0 + nrm(ks[12], (DEPTH, HG_VWIDTH), 0.02),
        'w_mem_k': nrm(ks[13], (DEPTH, D_MODEL, MEM_WIDTH), D_MODEL ** -0.5),
        'w_mem_v': nrm(ks[14], (DEPTH, D_MODEL, MEM_WIDTH), D_MODEL ** -0.5),
        'w_br_pool': nrm(ks[15], (DEPTH, POOL_WIDTH, D_MODEL), POOL_WIDTH ** -0.5),
        'w_br_hg': nrm(ks[16], (DEPTH, HG_VWIDTH, D_MODEL), HG_VWIDTH ** -0.5),
        'w_br_mem': nrm(ks[17], (DEPTH, MEM_WIDTH, D_MODEL), MEM_WIDTH ** -0.5),
        'w_out': nrm(ks[18], (DEPTH, D_MODEL, D_MODEL), DN_BETA * D_MODEL ** -0.5),
        'ln1_g': 1.0 + nrm(ks[19], (DEPTH, D_MODEL), 0.02),
        'ln1_b': nrm(ks[20], (DEPTH, D_MODEL), 0.02),
        'w_gate': nrm(ks[21], (DEPTH, D_MODEL, D_FF), D_MODEL ** -0.5),
        'w_up': nrm(ks[22], (DEPTH, D_MODEL, D_FF), D_MODEL ** -0.5),
        'conv_w': nrm(ks[23], (DEPTH, CONV_W, D_FF), 0.5),
        'conv_b': nrm(ks[24], (DEPTH, D_FF), 0.02),
        'w_down': nrm(ks[25], (DEPTH, D_FF, D_MODEL), DN_BETA * D_FF ** -0.5),
        'ln2_g': 1.0 + nrm(ks[26], (DEPTH, D_MODEL), 0.02),
        'ln2_b': nrm(ks[27], (DEPTH, D_MODEL), 0.02),
    }


def reference(x_prompt, x_sample, state_pool, state_hgrn, state_ffn_conv, cache_mem_k, cache_mem_v, mem_prompt,
              lb_logits, w_in, w_pool_grp, pool_scale, hg_norm_g, w_mem_k, w_mem_v, w_br_pool, w_br_hg, w_br_mem,
              w_out, ln1_g, ln1_b, w_gate, w_up, conv_w, conv_b, w_down, ln2_g, ln2_b):
    lower_bounds = jnp.cumsum(jax.nn.softmax(lb_logits.astype(jnp.float32), axis=0), axis=0)
    dt = x_prompt.dtype
    n_prompt = x_prompt.shape[0]
    n_mem = mem_prompt.shape[1]
    hp, hs = x_prompt, x_sample
    pool_p, hgrn_p, conv_p, memk_p, memv_p = [], [], [], [], []
    pool_s, hgrn_s, conv_s = [], [], []
    for l in range(DEPTH):
        p = {'w_in': w_in[l], 'w_pool_grp': w_pool_grp[l], 'pool_scale': pool_scale[l], 'hg_norm_g': hg_norm_g[l],
             'w_br_pool': w_br_pool[l], 'w_br_hg': w_br_hg[l], 'w_br_mem': w_br_mem[l], 'w_out': w_out[l],
             'ln1_g': ln1_g[l], 'ln1_b': ln1_b[l], 'w_gate': w_gate[l], 'w_up': w_up[l], 'conv_w': conv_w[l],
             'conv_b': conv_b[l], 'w_down': w_down[l], 'ln2_g': ln2_g[l], 'ln2_b': ln2_b[l]}
        lb = lower_bounds[l]
        mk = (mem_prompt @ w_mem_k[l]).reshape(n_prompt, n_mem, MEM_HEADS, MEM_HDIM)
        mv = (mem_prompt @ w_mem_v[l]).reshape(n_prompt, n_mem, MEM_HEADS, MEM_HDIM)
        hp, np_pool, np_hgrn, np_conv = decoder_layer(
            hp, jnp.zeros((n_prompt, POOL_BUF, POOL_WIDTH), dt),
            jnp.zeros((n_prompt, HG_HEADS, HG_KDIM, HG_VDIM), dt),
            jnp.zeros((n_prompt, CONV_W - 1, D_FF), dt), mk, mv, 0, lb, p)
        pool_p.append(np_pool)
        hgrn_p.append(np_hgrn)
        conv_p.append(np_conv)
        memk_p.append(mk)
        memv_p.append(mv)
        hs, ns_pool, ns_hgrn, ns_conv = decoder_layer(
            hs, state_pool[l], state_hgrn[l], state_ffn_conv[l], cache_mem_k[l], cache_mem_v[l], PAST_LEN, lb, p)
        pool_s.append(ns_pool)
        hgrn_s.append(ns_hgrn)
        conv_s.append(ns_conv)
    return (hp, hs, jnp.stack(pool_p), jnp.stack(hgrn_p), jnp.stack(conv_p), jnp.stack(memk_p), jnp.stack(memv_p),
            jnp.stack(pool_s), jnp.stack(hgrn_s), jnp.stack(conv_s))
```

```cpp
#include <hip/hip_runtime.h>
#include <hip/hip_cooperative_groups.h>
#include <cstdio>
#include <cstdint>
namespace cg = cooperative_groups;

constexpr int DM = 1024, NB = 8, SEQ = 2048, DB = 128, DSEQ = 4;
constexpr int MP = NB * SEQ, MS = DB * DSEQ, MT = MP + MS;
constexpr int INC = 5632, DFF = 2816, MEML = 256;
constexpr float DN_ALPHA = 1.189207115002721f;
constexpr float LN_EPS = 1e-5f, RMS_EPS = 1e-6f;
constexpr size_t O_Y = 0, O_POOLP = 17301504, O_HGP = 17332224, O_CONVP = 17856512, O_MEMK = 17901568, O_MEMV = 18425856,
                 O_POOLS = 18950144, O_HGS = 19441664, O_CONVS = 27830272, O_END = 28551168;
constexpr size_t OY_LF = 0, OY_Q = 8650752, OY_KK = 12976128;
constexpr size_t MiB = 1u << 20;
constexpr size_t WS_CTL = 0, CTL_BYTES = 32768, WS_LBT = 65536;
constexpr size_t WS_WGU = 1 * MiB, WS_WDOWN = 12 * MiB, WS_WOUT = 18 * MiB, WS_WBR = 20 * MiB;
constexpr size_t WS_XH = 22 * MiB;
constexpr size_t WS_GATE = 55 * MiB;
constexpr size_t WS_UA = 154 * MiB;
constexpr size_t WS_V = WS_UA + 17301504, WS_G = WS_V + 17301504, WS_QC = WS_G + 17301504;
constexpr size_t WS_WIN = WS_QC + 8650752;
constexpr size_t WS_WMEM = WS_WIN + 11534336, WS_MEMH = WS_WMEM + 1048576;
constexpr size_t WS_OB = WS_WIN;
constexpr size_t WS_A16 = 55 * MiB, WS_U16 = 146 * MiB;
constexpr size_t WS_END = 256 * MiB;
static_assert(WS_MEMH + 4194304 <= WS_END && WS_OB + 34603008 <= WS_END && WS_U16 + 95158272 <= WS_END && WS_A16 + 95158272 <= WS_U16, "ws map");
static_assert(WS_XH + 34603008 <= WS_GATE && WS_GATE + 103809024 <= WS_UA, "ws map 2");
constexpr int LDS_BYTES = 147456;

#define LAS __attribute__((address_space(3)))
typedef unsigned short bf16_t;
typedef short bf16x8 __attribute__((ext_vector_type(8)));
typedef float f32x4 __attribute__((ext_vector_type(4)));
typedef float f32x2 __attribute__((ext_vector_type(2)));
typedef unsigned u32x4 __attribute__((ext_vector_type(4)));
typedef unsigned u32x2 __attribute__((ext_vector_type(2)));

__device__ __forceinline__ unsigned cvt_pk(float lo, float hi) { unsigned r; asm volatile("v_cvt_pk_bf16_f32 %0, %1, %2" : "=v"(r) : "v"(lo), "v"(hi)); return r; }
__device__ __forceinline__ bf16_t f2bf(float f) { return (bf16_t)(cvt_pk(f, 0.f) & 0xffffu); }
__device__ __forceinline__ float bf2f(unsigned h) { return __uint_as_float(h << 16); }
__device__ __forceinline__ float bflo(unsigned w) { return __uint_as_float(w << 16); }
__device__ __forceinline__ float bfhi(unsigned w) { return __uint_as_float(w & 0xffff0000u); }
__device__ __forceinline__ u32x2 pk4(f32x4 v) { u32x2 r; r.x = cvt_pk(v[0], v[1]); r.y = cvt_pk(v[2], v[3]); return r; }
__device__ __forceinline__ f32x4 unpk4(u32x2 w) { return (f32x4){bflo(w.x), bfhi(w.x), bflo(w.y), bfhi(w.y)}; }
__device__ __forceinline__ void st8_coh(void* p, u32x2 v) { __hip_atomic_store((unsigned long long*)p, ((unsigned long long)v.y << 32) | v.x, __ATOMIC_RELAXED, __HIP_MEMORY_SCOPE_SYSTEM); }
__device__ __forceinline__ float sigmoidf_(float x) { return 1.0f / (1.0f + __expf(-x)); }
__device__ __forceinline__ float wave_sum(float v) {
#pragma unroll
    for (int o = 1; o < 64; o <<= 1) v += __shfl_xor(v, o);
    return v;
}

struct Args {
    const float* in[28];
    float* out; unsigned char* ws;
    int stop, pad;
};
#ifndef STOP_RT
#define STOP_RT 99
#endif
#ifndef P2_MASK
#define P2_MASK 31
#endif
enum { I_XP = 0, I_XS, I_SPOOL, I_SHG, I_SCONV, I_CK, I_CV, I_MEMP, I_LB, I_WIN, I_WGRP, I_PSCALE, I_HGG, I_WMK, I_WMV, I_WBP, I_WBH, I_WBM,
       I_WOUT, I_LN1G, I_LN1B, I_WGATE, I_WUP, I_CONVW, I_CONVB, I_WDOWN, I_LN2G, I_LN2B };

namespace pg8 {
#define PG8_LAS __attribute__((address_space(3)))
typedef unsigned short bf16_t;
typedef short bf16x8 __attribute__((ext_vector_type(8)));
typedef float f32x4 __attribute__((ext_vector_type(4)));
typedef unsigned u32x4 __attribute__((ext_vector_type(4)));
constexpr int BM = 256, BK = 64, HALF = 128, HTB = HALF * BK * 2  , STAGE_BYTES = 8 * HTB, NXCD = 8, WGM = 8;

__host__ __device__ __forceinline__ int lds_byte(int r, int c) { const int st = (r >> 4) * 2 + (c >> 5), rr = r & 15, cc = c & 31, ob = rr * 64 + cc * 2; return st * 1024 + (ob ^ (((ob >> 9) & 1) << 5)); }
__host__ __device__ __forceinline__ void stage_rc(int b, int& R, int& C) { const int st = b / 1024, sb = b % 1024, swz = sb ^ (((sb >> 9) & 1) << 5); R = (st >> 1) * 16 + swz / 64; C = (st & 1) * 32 + (swz % 64) / 2; }
__host__ __device__ __forceinline__ int perm32(int rho) { const int n = rho >> 4, i = rho & 15; return 8 * (i >> 2) + 4 * n + (i & 3); }

struct Unit { int pm, pn; };
struct Gemm { const bf16_t* A; const bf16_t* Bt; int M, N, K, ld; };

struct StaticOrder {
    int nM, nN, nwg, G, c;
    __host__ __device__ void init(int M, int N, int G_, int c_) { nM = M / BM; nN = N / BM; nwg = nM * nN; G = G_; c = c_; }
    __host__ __device__ bool next(int i, Unit& u) const {
        const long L = (long)i * G + c; if (L >= nwg) return false;
        int wgid = (int)L; { const int q = nwg / NXCD, r = nwg % NXCD, xcd = wgid % NXCD, off = wgid / NXCD; wgid = (xcd < r ? xcd * (q + 1) : r * (q + 1) + (xcd - r) * q) + off; }
        const int nig = WGM * nN, gid = wgid / nig, fm = gid * WGM, gsz = (nM - fm) < WGM ? (nM - fm) : WGM;
        u.pm = fm + ((wgid % nig) % gsz); u.pn = (wgid % nig) / gsz; return true;
    }
    __device__ __forceinline__ void a_ready(const Unit&) const {}
    __device__ __forceinline__ void done(const Unit&) const {}
};

struct XcdOrder {
    int nN, nloc, x, r, npm, mode;
    __host__ __device__ void init(int M, int N, int G_, int c_) { nN = N / BM; nloc = G_ >> 3; x = c_ & 7; r = c_ >> 3; mode = (M == 2048) ? 1 : 0; npm = mode ? 1 : (8 + (x < 2 ? 1 : 0)); }
    __host__ __device__ void own(int x_, int r_, int nloc_) { x = x_; r = r_; nloc = nloc_; npm = mode ? 1 : (8 + (x < 2 ? 1 : 0)); }
    __host__ __device__ bool next(int i, Unit& u) const {
        const int idx = i * nloc + r; if (idx >= npm * nN) return false;
        const int k = idx % npm; u.pn = idx / npm; u.pm = mode ? x : (k < 8 ? x * 8 + k : 64 + x); return true;
    }
    __device__ __forceinline__ void a_ready(const Unit&) const {}
    __device__ __forceinline__ void done(const Unit&) const {}
};

#define EPI_LOOP(...) \
    _Pragma("unroll") for (int ai = 0; ai < 2; ++ai) _Pragma("unroll") for (int m = 0; m < 4; ++m) { const int row = row0 + ai * 128 + m * 16; \
    _Pragma("unroll") for (int bj = 0; bj < 2; ++bj) _Pragma("unroll") for (int n = 0; n < 2; ++n) { const int col = col0 + bj * 128 + n * 16; const f32x4 v = acc[ai][bj][m][n]; __VA_ARGS__ } asm volatile("" ::: "memory"); }

struct EpiIn {
    static constexpr bool PERM = false, AFTER_DRAIN = false;
    float* UA; bf16_t* Q; float* LF; bf16_t* KK; bf16_t* V; bf16_t* G; bf16_t* QC; bf16_t* GATE; const float* lbl;
    __device__ __forceinline__ void operator()(const f32x4 (&acc)[2][2][4][2], const Unit& u, int wr, int wc, int fr, int fq) const {
        const int row0 = u.pm * BM + wr * 64 + fr, colt = u.pn * BM, col0 = colt + wc * 32 + 4 * fq;
        if (colt < 256) {
            EPI_LOOP( *(f32x4*)(UA + (size_t)row * 256 + col) = v; )
        } else if (colt < 768) {
            EPI_LOOP( f32x4 o; _Pragma("unroll") for (int e = 0; e < 4; ++e) o[e] = v[e] * sigmoidf_(v[e]); *(u32x2*)(Q + (size_t)row * 512 + (col - 256)) = pk4(o); )
        } else if (colt < 1280) {
            EPI_LOOP( f32x4 lf, kk; const f32x4 lb = *(const f32x4*)(lbl + (col - 768));
                _Pragma("unroll") for (int e = 0; e < 4; ++e) { const float s = sigmoidf_(v[e]); lf[e] = __logf(lb[e] + (1.0f - lb[e]) * s); kk[e] = (1.0f - lb[e]) * (1.0f - s); }
                *(f32x4*)(LF + (size_t)row * 512 + (col - 768)) = lf; *(u32x2*)(KK + (size_t)row * 512 + (col - 768)) = pk4(kk); )
        } else if (colt < 1792) {
            EPI_LOOP( *(u32x2*)(V + (size_t)row * 512 + (col - 1280)) = pk4(v); )
        } else if (colt < 2304) {
            EPI_LOOP( f32x4 o; _Pragma("unroll") for (int e = 0; e < 4; ++e) o[e] = v[e] * sigmoidf_(v[e]); *(u32x2*)(G + (size_t)row * 512 + (col - 1792)) = pk4(o); )
        } else if (colt < 2560) {
            EPI_LOOP( *(u32x2*)(QC + (size_t)row * 256 + (col - 2304)) = pk4(v * 0.125f); )
        } else {
            EPI_LOOP( f32x4 o; _Pragma("unroll") for (int e = 0; e < 4; ++e) o[e] = sigmoidf_(v[e]); *(u32x2*)(GATE + (size_t)row * 3072 + (col - 2560)) = pk4(o); )
        }
    }
};
struct EpiMem {
    static constexpr bool PERM = false, AFTER_DRAIN = false;
    float* KO; float* VO;
    __device__ __forceinline__ void operator()(const f32x4 (&acc)[2][2][4][2], const Unit& u, int wr, int wc, int fr, int fq) const {
        const int row0 = u.pm * BM + wr * 64 + fr, colt = u.pn * BM, col0 = wc * 32 + 4 * fq;
        float* O = colt == 0 ? KO : VO;
        EPI_LOOP( *(f32x4*)(O + (size_t)row * 256 + col) = v; )
    }
};
template <int J> struct EpiBr {
    static constexpr bool PERM = false, AFTER_DRAIN = false;
    const bf16_t* GATE; float* MF; bf16_t* MH;
    __device__ __forceinline__ void operator()(const f32x4 (&acc)[2][2][4][2], const Unit& u, int wr, int wc, int fr, int fq) const {
        const int row0 = u.pm * BM + wr * 64 + fr, col0 = u.pn * BM + wc * 32 + 4 * fq;
        EPI_LOOP( const f32x4 g = unpk4(*(const u32x2*)(GATE + (size_t)row * 3072 + J * 1024 + col)); f32x4 r = g * v; float* mp = MF + (size_t)row * 1024 + col;
            if (J > 0) r += *(const f32x4*)mp;
            if (J < 2) *(f32x4*)mp = r; else *(u32x2*)(MH + (size_t)row * 1024 + col) = pk4(r); )
    }
};
struct EpiOut {
    static constexpr bool PERM = false, AFTER_DRAIN = false;
    const float* xp; const float* xs; float* HP;
    __device__ __forceinline__ void operator()(const f32x4 (&acc)[2][2][4][2], const Unit& u, int wr, int wc, int fr, int fq) const {
        const int row0 = u.pm * BM + wr * 64 + fr, col0 = u.pn * BM + wc * 32 + 4 * fq;
        const float* xb = (u.pm * BM < MP) ? xp : (xs - (size_t)MP * 1024);
        EPI_LOOP( const f32x4 x = *(const f32x4*)(xb + (size_t)row * 1024 + col); *(f32x4*)(HP + (size_t)row * 1024 + col) = x * DN_ALPHA + v; )
    }
};
struct EpiFfn1 {
    static constexpr bool PERM = false, AFTER_DRAIN = false;
    bf16_t* A16; bf16_t* U16; float* convp; float* convs;
    __device__ __forceinline__ void operator()(const f32x4 (&acc)[2][2][4][2], const Unit& u, int wr, int wc, int fr, int fq) const {
        const int row0 = u.pm * BM + wr * 64 + fr, colt = u.pn * BM, col0 = colt + wc * 32 + 4 * fq;
        if (colt < DFF) {
            EPI_LOOP( st8_coh(A16 + (size_t)row * DFF + col, pk4(v));
                if (row < MP) { const int t = row & (SEQ - 1); if (t >= SEQ - 2) *(f32x4*)(convp + ((size_t)(row >> 11) * 2 + (t - (SEQ - 2))) * DFF + col) = v; }
                else { const int j = row & 3; if (j >= 2) *(f32x4*)(convs + ((size_t)((row - MP) >> 2) * 2 + (j - 2)) * DFF + col) = v; } )
        } else {
            EPI_LOOP( st8_coh(U16 + (size_t)row * DFF + (col - DFF), pk4(v)); )
        }
    }
};
struct EpiFfn2 {
    static constexpr bool PERM = false, AFTER_DRAIN = false;
    const bf16_t* H; float* YP;
    __device__ __forceinline__ void operator()(const f32x4 (&acc)[2][2][4][2], const Unit& u, int wr, int wc, int fr, int fq) const {
        const int row0 = u.pm * BM + wr * 64 + fr, col0 = u.pn * BM + wc * 32 + 4 * fq;
        EPI_LOOP( const f32x4 h = unpk4(*(const u32x2*)(H + (size_t)row * 1024 + col)); *(f32x4*)(YP + (size_t)row * 1024 + col) = h * DN_ALPHA + v; )
    }
};

template <class Epi, class Sched, bool ALIGN_EPI = false, bool SP2 = false>
__device__ __forceinline__ void gemm_phase(PG8_LAS unsigned char* lds, const Gemm g, const Sched& S, const Epi& E) {
    int tid_ = threadIdx.x; asm volatile("" : "+v"(tid_));
    const int tid = tid_, wid = __builtin_amdgcn_readfirstlane(tid >> 6), lane = tid & 63, wr = wid >> 2, wc = wid & 3, fr = lane & 15, fq = lane >> 4;
    const int K = g.ld, nt = g.K / BK;
    unsigned voffA[2], voffB[2];
#pragma unroll
    for (int i = 0; i < 2; ++i) { int R, C; stage_rc(tid * 16 + i * 8192, R, C); const int Rb = Epi::PERM ? ((R & ~31) + perm32(R & 31)) : R;
        voffA[i] = (unsigned)(R * K + C) * 2u; voffB[i] = (unsigned)(Rb * K + C) * 2u; }
    const size_t kstep = (size_t)(BK * 2);
    const size_t hstep = (size_t)HALF * K * 2;
    const size_t tstep = 2 * hstep;
    const unsigned ldsw = (unsigned)wid * 1024u;
    const int aoff = lds_byte(wr * 64 + fr, fq * 8), boff = lds_byte(wc * 32 + fr, fq * 8);
#define PG8_SA(b, h) (((b) * 2 + (h)) * HTB)
#define PG8_SB(b, h) ((4 + (b) * 2 + (h)) * HTB)
#define PG8_STAGE(bufoff, gbase, voff) do { _Pragma("unroll") for (int _i = 0; _i < 2; ++_i) \
        __builtin_amdgcn_global_load_lds((const unsigned*)((const char*)(gbase) + (voff)[_i]), (PG8_LAS unsigned*)(lds + (bufoff) + ldsw + _i * 8192), 16, 0, 0); } while (0)
#define PG8_LDA(dst, b, h) do { _Pragma("unroll") for (int m = 0; m < 4; ++m) _Pragma("unroll") for (int k = 0; k < 2; ++k) dst[m][k] = *(const PG8_LAS bf16x8*)(lds + PG8_SA(b, h) + aoff + m * 2048 + k * 1024); } while (0)
#define PG8_LDB(dst, b, h) do { _Pragma("unroll") for (int n = 0; n < 2; ++n) _Pragma("unroll") for (int k = 0; k < 2; ++k) dst[n][k] = *(const PG8_LAS bf16x8*)(lds + PG8_SB(b, h) + boff + n * 2048 + k * 1024); } while (0)
#define PG8_MMA(ai, bj, At, Bt) do { __builtin_amdgcn_s_setprio(1); _Pragma("unroll") for (int m = 0; m < 4; ++m) _Pragma("unroll") for (int n = 0; n < 2; ++n) _Pragma("unroll") for (int k = 0; k < 2; ++k) \
        acc[ai][bj][m][n] = __builtin_amdgcn_mfma_f32_16x16x32_bf16(Bt[n][k], At[m][k], acc[ai][bj][m][n], 0, 0, 0); __builtin_amdgcn_s_setprio(0); } while (0)
#define PG8_WAIT_V(n) asm volatile("s_waitcnt vmcnt(" #n ")" ::: "memory")
#define PG8_WAIT_L(n) asm volatile("s_waitcnt lgkmcnt(" #n ")" ::: "memory")
#define PG8_BAR __builtin_amdgcn_s_barrier()
#define PG8_SCHED __builtin_amdgcn_sched_barrier(0)
    Unit cur, nxt; int ui = 0;
    if (!S.next(0, cur)) return;
    f32x4 acc[2][2][4][2];
#pragma unroll
    for (int a = 0; a < 2; ++a)
#pragma unroll
        for (int b = 0; b < 2; ++b)
#pragma unroll
            for (int m = 0; m < 4; ++m)
#pragma unroll
                for (int n = 0; n < 2; ++n) acc[a][b][m][n] = (f32x4){0.f, 0.f, 0.f, 0.f};
    bf16x8 At[4][2], B0[2][2], B1[2][2];
    const char* cA = (const char*)g.A + (size_t)cur.pm * tstep; const char* cB = (const char*)g.Bt + (size_t)cur.pn * tstep;
    S.a_ready(cur);
    if constexpr (SP2) {
        PG8_STAGE(PG8_SB(0, 0), cB, voffB); PG8_STAGE(PG8_SB(0, 1), cB + hstep, voffB); PG8_STAGE(PG8_SA(0, 0), cA, voffA); PG8_STAGE(PG8_SA(0, 1), cA + hstep, voffA);
        if (wr == 1) PG8_BAR;
        PG8_WAIT_V(2); PG8_BAR;
        PG8_STAGE(PG8_SB(1, 0), cB + kstep, voffB); PG8_STAGE(PG8_SA(1, 0), cA + kstep, voffA); PG8_STAGE(PG8_SB(1, 1), cB + hstep + kstep, voffB);
        PG8_WAIT_V(6); PG8_BAR;
    } else {
        PG8_STAGE(PG8_SB(0, 0), cB, voffB); PG8_STAGE(PG8_SA(0, 0), cA, voffA); PG8_STAGE(PG8_SB(0, 1), cB + hstep, voffB); PG8_STAGE(PG8_SA(0, 1), cA + hstep, voffA);
        if (wr == 1) PG8_BAR;
        PG8_WAIT_V(4); PG8_BAR;
        PG8_STAGE(PG8_SB(1, 0), cB + kstep, voffB); PG8_STAGE(PG8_SA(1, 0), cA + kstep, voffA); PG8_STAGE(PG8_SB(1, 1), cB + hstep + kstep, voffB);
        PG8_WAIT_V(6); PG8_BAR;
    }
    for (;;) {
        const bool has_next = S.next(ui + 1, nxt);
        const char* nA = has_next ? (const char*)g.A + (size_t)nxt.pm * tstep : cA; const char* nB = has_next ? (const char*)g.Bt + (size_t)nxt.pn * tstep : cB;
        for (int t = 0; t < nt; t += 2) {
            const bool last = (t == nt - 2);
            const char* a1 = cA + (size_t)(t + 1) * kstep;
            const char* a2 = last ? nA : cA + (size_t)(t + 2) * kstep; const char* b2 = last ? nB : cB + (size_t)(t + 2) * kstep;
            const char* a3 = a2 + kstep; const char* b3 = b2 + kstep;
            if (last && has_next) S.a_ready(nxt);
            if constexpr (SP2) {
            PG8_LDB(B0, 0, 0); PG8_LDB(B1, 0, 1); PG8_SCHED; PG8_LDA(At, 0, 0); PG8_STAGE(PG8_SA(1, 1), a1 + hstep, voffA);
            PG8_WAIT_V(8); PG8_WAIT_L(0); PG8_BAR; PG8_MMA(0, 0, At, B0); PG8_MMA(0, 1, At, B1); PG8_BAR; PG8_SCHED;
            PG8_LDA(At, 0, 1); PG8_STAGE(PG8_SB(0, 0), b2, voffB); PG8_STAGE(PG8_SB(0, 1), b2 + hstep, voffB); PG8_STAGE(PG8_SA(0, 0), a2, voffA);
            PG8_WAIT_V(8); PG8_WAIT_L(0); PG8_BAR; PG8_MMA(1, 0, At, B0); PG8_MMA(1, 1, At, B1); PG8_BAR; PG8_SCHED;
            PG8_LDB(B0, 1, 0); PG8_LDB(B1, 1, 1); PG8_SCHED; PG8_LDA(At, 1, 0); PG8_STAGE(PG8_SA(0, 1), a2 + hstep, voffA);
            PG8_WAIT_V(8); PG8_WAIT_L(0); PG8_BAR; PG8_MMA(0, 0, At, B0); PG8_MMA(0, 1, At, B1); PG8_BAR; PG8_SCHED;
            PG8_LDA(At, 1, 1); PG8_STAGE(PG8_SB(1, 0), b3, voffB); PG8_STAGE(PG8_SB(1, 1), b3 + hstep, voffB); PG8_STAGE(PG8_SA(1, 0), a3, voffA);
            PG8_WAIT_V(8); PG8_WAIT_L(0); PG8_BAR; PG8_MMA(1, 0, At, B0); PG8_MMA(1, 1, At, B1); PG8_BAR; PG8_SCHED;
            } else {
            PG8_LDB(B0, 0, 0); PG8_SCHED; PG8_LDA(At, 0, 0); PG8_STAGE(PG8_SA(1, 1), a1 + hstep, voffA);
            PG8_WAIT_L(8); PG8_BAR; PG8_WAIT_L(0); PG8_MMA(0, 0, At, B0); PG8_BAR; PG8_SCHED;
            PG8_LDB(B1, 0, 1); PG8_STAGE(PG8_SB(0, 0), b2, voffB);
            PG8_BAR; PG8_WAIT_L(0); PG8_MMA(0, 1, At, B1); PG8_BAR;
            PG8_LDA(At, 0, 1); PG8_STAGE(PG8_SA(0, 0), a2, voffA);
            PG8_BAR; PG8_WAIT_L(0); PG8_MMA(1, 0, At, B0); PG8_BAR; PG8_SCHED;
            PG8_STAGE(PG8_SB(0, 1), b2 + hstep, voffB);
            PG8_WAIT_V(6); PG8_BAR; PG8_MMA(1, 1, At, B1); PG8_BAR;
            PG8_LDB(B0, 1, 0); PG8_SCHED; PG8_LDA(At, 1, 0); PG8_STAGE(PG8_SA(0, 1), a2 + hstep, voffA);
            PG8_WAIT_L(8); PG8_BAR; PG8_WAIT_L(0); PG8_MMA(0, 0, At, B0); PG8_BAR; PG8_SCHED;
            PG8_LDB(B1, 1, 1); PG8_STAGE(PG8_SB(1, 0), b3, voffB);
            PG8_BAR; PG8_WAIT_L(0); PG8_MMA(0, 1, At, B1); PG8_BAR;
            PG8_LDA(At, 1, 1); PG8_STAGE(PG8_SA(1, 0), a3, voffA);
            PG8_BAR; PG8_WAIT_L(0); PG8_MMA(1, 0, At, B0); PG8_BAR; PG8_SCHED;
            PG8_STAGE(PG8_SB(1, 1), b3 + hstep, voffB);
            PG8_WAIT_V(6); PG8_BAR; PG8_MMA(1, 1, At, B1); PG8_BAR;
            }
        }
        if constexpr (ALIGN_EPI) { if (wr == 0) PG8_BAR; }
        if constexpr (!Epi::AFTER_DRAIN) { E(acc, cur, wr, wc, fr, fq); S.done(cur); }
        if (!has_next) break;
#pragma unroll
        for (int a = 0; a < 2; ++a)
#pragma unroll
            for (int b = 0; b < 2; ++b)
#pragma unroll
                for (int m = 0; m < 4; ++m)
#pragma unroll
                    for (int n = 0; n < 2; ++n) acc[a][b][m][n] = (f32x4){0.f, 0.f, 0.f, 0.f};
        cur = nxt; cA = nA; cB = nB; ++ui;
        if constexpr (ALIGN_EPI) { if (wr == 1) PG8_BAR; }
    }
    PG8_WAIT_V(0);
    if constexpr (!ALIGN_EPI) { if (wr == 0) PG8_BAR; }
    PG8_BAR;
    if constexpr (Epi::AFTER_DRAIN) { E.fused(acc, cur, wr, wc, fr, fq, lds, wid, lane); S.done(cur); }
#undef PG8_SA
#undef PG8_SB
#undef PG8_STAGE
#undef PG8_LDA
#undef PG8_LDB
#undef PG8_MMA
#undef PG8_WAIT_V
#undef PG8_WAIT_L
#undef PG8_BAR
#undef PG8_SCHED
}
}

struct Ctx {
    LAS unsigned char* lds;
    int wave, G, bid, xcd, rank, nloc;
};
__device__ __forceinline__ int fresh_tid() { int t = threadIdx.x; asm volatile("" : "+v"(t)); return t; }
__device__ __forceinline__ int own_nrows(int x) { return 2048 + (x < 2 ? 256 : 0); }
__device__ __forceinline__ int own_row(int x, int l) { return l < 2048 ? x * 2048 + l : MP + x * 256 + (l - 2048); }
#define LDS_WAIT() asm volatile("s_waitcnt lgkmcnt(0)" ::: "memory")
__device__ __forceinline__ bf16x8 ldfrag(const LAS bf16_t* base, int stride, int row, int k0) { return *(const LAS bf16x8*)(base + row * stride + k0); }
#define MFMA16(a, b, c) __builtin_amdgcn_mfma_f32_16x16x32_bf16((a), (b), (c), 0, 0, 0)

__device__ __forceinline__ void p0_transpose_item(const float* W, int N, bf16_t* WT, int ldT, int row_off, int col_off, LAS float* scr, int item, int lane) {
    const int nblk = N / 32, kb = item / nblk, nb = item % nblk, k0 = 64 * kb, n0 = 32 * nb;
#pragma unroll 8
    for (int i = 0; i < 32; ++i) { const int kk = 2 * i + (lane >> 5); scr[kk * 33 + (lane & 31)] = W[(size_t)(k0 + kk) * N + n0 + (lane & 31)]; }
    LDS_WAIT(); asm volatile("" ::: "memory");
    const int c = lane & 7;
#pragma unroll
    for (int j = 0; j < 4; ++j) { const int n = (lane >> 3) + 8 * j; const LAS float* s = scr + (8 * c) * 33 + n;
        u32x4 o; o.x = cvt_pk(s[0 * 33], s[1 * 33]); o.y = cvt_pk(s[2 * 33], s[3 * 33]); o.z = cvt_pk(s[4 * 33], s[5 * 33]); o.w = cvt_pk(s[6 * 33], s[7 * 33]);
        *(u32x4*)(WT + (size_t)(row_off + n0 + n) * ldT + col_off + k0 + 8 * c) = o; }
    LDS_WAIT(); asm volatile("" ::: "memory");
}
__device__ __forceinline__ void cvt_rows(const float* src, bf16_t* dst, size_t n8, size_t gt, size_t GT) {
    for (size_t i = gt; i < n8; i += GT) { const f32x4 a = *(const f32x4*)(src + i * 8), b = *(const f32x4*)(src + i * 8 + 4);
        u32x4 o; o.x = cvt_pk(a[0], a[1]); o.y = cvt_pk(a[2], a[3]); o.z = cvt_pk(b[0], b[1]); o.w = cvt_pk(b[2], b[3]); *(u32x4*)(dst + i * 8) = o; }
}

__device__ __forceinline__ void p0_prep(const Ctx& C, const Args& a) {
    unsigned char* ws = a.ws;
    bf16_t* WinT = (bf16_t*)(ws + WS_WIN); bf16_t* WmemT = (bf16_t*)(ws + WS_WMEM); bf16_t* WbrT = (bf16_t*)(ws + WS_WBR); bf16_t* WoutT = (bf16_t*)(ws + WS_WOUT);
    bf16_t* WguT = (bf16_t*)(ws + WS_WGU); bf16_t* WdownT = (bf16_t*)(ws + WS_WDOWN);
    const int tid = fresh_tid(), lane = tid & 63;
    LAS float* scr = (LAS float*)(C.lds + C.wave * 16384);
    const int gw = C.bid * 8 + C.wave, NGW = C.G * 8;
    constexpr int I_IN = 16 * 176, I_MK = 16 * 8, I_BH = 8 * 32, I_BM = 4 * 32, I_OUT = 16 * 32, I_GT = 16 * 88, I_DN = 44 * 32;
    constexpr int NITEMS = I_IN + 2 * I_MK + I_BH + I_BM + I_OUT + 2 * I_GT + I_DN;
    for (int it = gw; it < NITEMS; it += NGW) {
        int r = it;
        if (r < I_IN) { p0_transpose_item(a.in[I_WIN], INC, WinT, 1024, 0, 0, scr, r, lane); continue; } r -= I_IN;
        if (r < I_MK) { p0_transpose_item(a.in[I_WMK], 256, WmemT, 1024, 0, 0, scr, r, lane); continue; } r -= I_MK;
        if (r < I_MK) { p0_transpose_item(a.in[I_WMV], 256, WmemT, 1024, 256, 0, scr, r, lane); continue; } r -= I_MK;
        if (r < I_BH) { p0_transpose_item(a.in[I_WBH], 1024, WbrT, 1024, 0, 256, scr, r, lane); continue; } r -= I_BH;
        if (r < I_BM) { p0_transpose_item(a.in[I_WBM], 1024, WbrT, 1024, 0, 768, scr, r, lane); continue; } r -= I_BM;
        if (r < I_OUT) { p0_transpose_item(a.in[I_WOUT], 1024, WoutT, 1024, 0, 0, scr, r, lane); continue; } r -= I_OUT;
        if (r < I_GT) { p0_transpose_item(a.in[I_WGATE], DFF, WguT, 1024, 0, 0, scr, r, lane); continue; } r -= I_GT;
        if (r < I_GT) { p0_transpose_item(a.in[I_WUP], DFF, WguT, 1024, DFF, 0, scr, r, lane); continue; } r -= I_GT;
        p0_transpose_item(a.in[I_WDOWN], 1024, WdownT, DFF, 0, 0, scr, r, lane);
    }
    const size_t gt = (size_t)C.bid * 512 + tid, GT = (size_t)C.G * 512;
    for (size_t i = gt; i < 256 * 1024; i += GT) {
        const int k = (int)(i >> 10), n = (int)(i & 1023), g = k >> 6;
        const float* wg = a.in[I_WGRP] + (size_t)k * 64; const float* sc = a.in[I_PSCALE] + g * 64; const float* wb = a.in[I_WBP] + (size_t)(g * 64) * 1024 + n;
        float s = 0.f;
#pragma unroll 8
        for (int d = 0; d < 64; ++d) s += wg[d] * sc[d] * wb[(size_t)d * 1024];
        WbrT[(size_t)n * 1024 + k] = f2bf(s);
    }
    if (gt < 512) { const float* l = a.in[I_LB]; ((float*)(ws + WS_LBT))[gt] = 1.0f / (1.0f + __expf(l[512 + gt] - l[gt])); }
    bf16_t* Xh = (bf16_t*)(ws + WS_XH);
#if defined(NAN_MEMKV)
    for (size_t i = gt; i < 2 * 524288; i += GT) ((unsigned*)(a.out + O_MEMK))[i] = 0x7fc00000u;
#endif
    {
        const int ox = C.xcd, orank = C.rank, onloc = C.nloc, onr = own_nrows(ox);
        for (int i = orank * 512 + tid; i < onr * 128; i += onloc * 512) { const int row = own_row(ox, i >> 7), g8 = (i & 127) * 8;
            const float* src = row < MP ? a.in[I_XP] + (size_t)row * 1024 + g8 : a.in[I_XS] + (size_t)(row - MP) * 1024 + g8;
            const f32x4 v0 = *(const f32x4*)src, v1 = *(const f32x4*)(src + 4);
            u32x4 o; o.x = cvt_pk(v0[0], v0[1]); o.y = cvt_pk(v0[2], v0[3]); o.z = cvt_pk(v1[0], v1[1]); o.w = cvt_pk(v1[2], v1[3]); *(u32x4*)(Xh + (size_t)row * 1024 + g8) = o; }
        for (int i = orank * 512 + tid; i < 256 * 128; i += onloc * 512) { const size_t e = ((size_t)(ox * 256 + (i >> 7))) * 1024 + (i & 127) * 8;
            const f32x4 v0 = *(const f32x4*)(a.in[I_MEMP] + e), v1 = *(const f32x4*)(a.in[I_MEMP] + e + 4);
            u32x4 o; o.x = cvt_pk(v0[0], v0[1]); o.y = cvt_pk(v0[2], v0[3]); o.z = cvt_pk(v1[0], v1[1]); o.w = cvt_pk(v1[2], v1[3]); *(u32x4*)((bf16_t*)(ws + WS_MEMH) + e) = o; }
    }
}

__device__ __forceinline__ void hgrn_prompt_unit(const Ctx& C, const Args& a, int unit) {
    const int b = unit >> 4, h = (unit >> 2) & 3, eq = unit & 3;
    const float* LF = a.out + OY_LF; const bf16_t* Q = (const bf16_t*)(a.out + OY_Q); const bf16_t* KK = (const bf16_t*)(a.out + OY_KK);
    const bf16_t* V = (const bf16_t*)(a.ws + WS_V); float* OB = (float*)(a.ws + WS_OB);
    LAS bf16_t* Qp = (LAS bf16_t*)C.lds;
    LAS bf16_t* Kp = Qp + 64 * 136;
    LAS bf16_t* KT = Kp + 64 * 136;
    LAS bf16_t* VT = KT + 128 * 72;
    LAS bf16_t* SC = VT + 32 * 72;
    LAS bf16_t* ST = SC + 64 * 72;
    LAS float* blast = (LAS float*)(ST + 32 * 136);
    LAS float* part = blast + 128;
    const int tid = fresh_tid(), lane = tid & 63, w = C.wave, l16 = lane & 15, q4 = lane >> 4;
    const int d = tid & 127, tq = tid >> 7;
    for (int i = tid; i < 32 * 136 / 2; i += 512) ((LAS unsigned*)ST)[i] = 0u;
    f32x4 sacc[2]; sacc[0] = (f32x4){0.f, 0.f, 0.f, 0.f}; sacc[1] = sacc[0];
    for (int c = 0; c < SEQ / 64; ++c) {
        const int rbase = b * SEQ + c * 64;
        float bl[16], qv[16], kv[16]; float run = 0.f;
#pragma unroll
        for (int i = 0; i < 16; ++i) { const size_t idx = (size_t)(rbase + tq * 16 + i) * 512 + h * 128 + d;
            run += LF[idx]; bl[i] = run; qv[i] = bf2f(Q[idx]); kv[i] = bf2f(KK[idx]); }
        part[tq * 128 + d] = run;
        const int vt = tid >> 3, ve = (tid & 7) * 4;
        const u32x2 vraw = *(const u32x2*)(V + (size_t)(rbase + vt) * 512 + h * 128 + eq * 32 + ve);
        __syncthreads();
        float off = 0.f, tot = 0.f;
#pragma unroll
        for (int p = 0; p < 4; ++p) { const float x = part[p * 128 + d]; tot += x; if (p < tq) off += x; }
        if (tq == 0) blast[d] = tot;
        unsigned ktp[8];
#pragma unroll
        for (int i = 0; i < 16; i += 2) {
            const float b0 = bl[i] + off, b1 = bl[i + 1] + off;
            Qp[(tq * 16 + i) * 136 + d] = f2bf(qv[i] * __expf(b0)); Qp[(tq * 16 + i + 1) * 136 + d] = f2bf(qv[i + 1] * __expf(b1));
            Kp[(tq * 16 + i) * 136 + d] = f2bf(kv[i] * __expf(-b0)); Kp[(tq * 16 + i + 1) * 136 + d] = f2bf(kv[i + 1] * __expf(-b1));
            ktp[i >> 1] = cvt_pk(kv[i] * __expf(tot - b0), kv[i + 1] * __expf(tot - b1));
        }
        *(LAS u32x4*)(KT + d * 72 + tq * 16) = (u32x4){ktp[0], ktp[1], ktp[2], ktp[3]};
        *(LAS u32x4*)(KT + d * 72 + tq * 16 + 8) = (u32x4){ktp[4], ktp[5], ktp[6], ktp[7]};
        VT[(ve + 0) * 72 + vt] = (bf16_t)(vraw.x & 0xffffu); VT[(ve + 1) * 72 + vt] = (bf16_t)(vraw.x >> 16);
        VT[(ve + 2) * 72 + vt] = (bf16_t)(vraw.y & 0xffffu); VT[(ve + 3) * 72 + vt] = (bf16_t)(vraw.y >> 16);
        __syncthreads();
#pragma unroll
        for (int bi = 0; bi < 2; ++bi) {
            const int blk = 2 * w + bi, tb = blk >> 2, sb = blk & 3;
            f32x4 acc = (f32x4){0.f, 0.f, 0.f, 0.f};
            if (sb <= tb) {
#pragma unroll
                for (int kk = 0; kk < 4; ++kk) acc = MFMA16(ldfrag(Kp, 136, sb * 16 + l16, kk * 32 + q4 * 8), ldfrag(Qp, 136, tb * 16 + l16, kk * 32 + q4 * 8), acc);
                const int t = tb * 16 + l16, s0 = sb * 16 + 4 * q4;
#pragma unroll
                for (int j = 0; j < 4; ++j) if (s0 + j > t) acc[j] = 0.f;
            }
            *(LAS u32x2*)(SC + (tb * 16 + l16) * 72 + sb * 16 + 4 * q4) = pk4(acc);
        }
        __syncthreads();
        {
            const int tb = w >> 1, eb = w & 1;
            f32x4 acc = (f32x4){0.f, 0.f, 0.f, 0.f};
#pragma unroll
            for (int kk = 0; kk < 2; ++kk) acc = MFMA16(ldfrag(VT, 72, eb * 16 + l16, kk * 32 + q4 * 8), ldfrag(SC, 72, tb * 16 + l16, kk * 32 + q4 * 8), acc);
#pragma unroll
            for (int kk = 0; kk < 4; ++kk) acc = MFMA16(ldfrag(ST, 136, eb * 16 + l16, kk * 32 + q4 * 8), ldfrag(Qp, 136, tb * 16 + l16, kk * 32 + q4 * 8), acc);
            *(f32x4*)(OB + (size_t)(rbase + tb * 16 + l16) * 512 + h * 128 + eq * 32 + eb * 16 + 4 * q4) = acc;
        }
        {
            const f32x4 bl4 = *(const LAS f32x4*)(blast + 16 * w + 4 * q4);
            f32x4 dec; _Pragma("unroll") for (int j = 0; j < 4; ++j) dec[j] = __expf(bl4[j]);
#pragma unroll
            for (int nb = 0; nb < 2; ++nb) {
                sacc[nb] = sacc[nb] * dec;
#pragma unroll
                for (int kk = 0; kk < 2; ++kk) sacc[nb] = MFMA16(ldfrag(KT, 72, 16 * w + l16, kk * 32 + q4 * 8), ldfrag(VT, 72, nb * 16 + l16, kk * 32 + q4 * 8), sacc[nb]);
            }
        }
        __syncthreads();
#pragma unroll
        for (int nb = 0; nb < 2; ++nb) *(LAS u32x2*)(ST + (nb * 16 + l16) * 136 + 16 * w + 4 * q4) = pk4(sacc[nb]);
    }
    float* SO = a.out + O_HGP + (size_t)(b * 4 + h) * 16384;
#pragma unroll
    for (int nb = 0; nb < 2; ++nb)
#pragma unroll
        for (int j = 0; j < 4; ++j) SO[(size_t)(16 * w + 4 * q4 + j) * 128 + eq * 32 + nb * 16 + l16] = sacc[nb][j];
    __syncthreads();
}

__device__ __forceinline__ void hgrn_sample_unit(const Ctx& C, const Args& a, int unit) {
    const int b = unit >> 2, h = unit & 3;
    const float* LF = a.out + OY_LF; const bf16_t* Q = (const bf16_t*)(a.out + OY_Q); const bf16_t* KK = (const bf16_t*)(a.out + OY_KK);
    const bf16_t* V = (const bf16_t*)(a.ws + WS_V); float* OB = (float*)(a.ws + WS_OB);
    LAS float* qs = (LAS float*)C.lds; LAS float* ks = qs + 512; LAS float* fs = ks + 512; LAS float* vs = fs + 512; LAS float* red = vs + 512;
    const int tid = fresh_tid();
    { const int j = tid >> 7, d = tid & 127; const size_t idx = (size_t)(MP + b * 4 + j) * 512 + h * 128 + d;
      qs[tid] = bf2f(Q[idx]); ks[tid] = bf2f(KK[idx]); fs[tid] = __expf(LF[idx]); vs[tid] = bf2f(V[idx]); }
    const int e = (tid & 31) * 4, dg = tid >> 5, d0 = dg * 8;
    const float* S0 = a.in[I_SHG] + (size_t)(b * 4 + h) * 16384;
    f32x4 S[8];
#pragma unroll
    for (int i = 0; i < 8; ++i) S[i] = *(const f32x4*)(S0 + (size_t)(d0 + i) * 128 + e);
    __syncthreads();
#pragma unroll
    for (int j = 0; j < 4; ++j) {
        const f32x4 v4 = *(const LAS f32x4*)(vs + j * 128 + e); f32x4 po = (f32x4){0.f, 0.f, 0.f, 0.f};
#pragma unroll
        for (int i = 0; i < 8; ++i) { const float f = fs[j * 128 + d0 + i], k = ks[j * 128 + d0 + i], q = qs[j * 128 + d0 + i]; S[i] = S[i] * f + v4 * k; po += S[i] * q; }
        *(LAS f32x4*)(red + (j * 16 + dg) * 128 + e) = po;
    }
    __syncthreads();
    { const int j = tid >> 7, ee = tid & 127; float s = 0.f;
#pragma unroll
      for (int g = 0; g < 16; ++g) s += red[(j * 16 + g) * 128 + ee];
      OB[(size_t)(MP + b * 4 + j) * 512 + h * 128 + ee] = s; }
    float* SO = a.out + O_HGS + (size_t)(b * 4 + h) * 16384;
#pragma unroll
    for (int i = 0; i < 8; ++i) *(f32x4*)(SO + (size_t)(d0 + i) * 128 + e) = S[i];
    __syncthreads();
}

__device__ __forceinline__ void attn_unit(const Ctx& C, const Args& a, int unit) {
    int b, h, r0, Lq; const float *Ks, *Vs;
    if (unit < 512) { b = unit >> 6; h = (unit >> 4) & 3; r0 = b * SEQ + (unit & 15) * 128; Lq = 128; Ks = a.out + O_MEMK + (size_t)b * 65536; Vs = a.out + O_MEMV + (size_t)b * 65536; }
    else { const int u2 = unit - 512; b = u2 >> 2; h = u2 & 3; r0 = MP + b * 4; Lq = 4; Ks = a.in[I_CK] + (size_t)b * 65536; Vs = a.in[I_CV] + (size_t)b * 65536; }
    const bf16_t* QC = (const bf16_t*)(a.ws + WS_QC); bf16_t* YC = (bf16_t*)(a.ws + WS_XH);
    LAS float* Kf = (LAS float*)C.lds;
    LAS float* Vf = Kf + 256 * 68;
    const int tid = fresh_tid();
#pragma unroll
    for (int i = 0; i < 8; ++i) { const int idx = tid + i * 512, key = idx >> 4, d4 = (idx & 15) * 4;
        *(LAS f32x4*)(Kf + key * 68 + d4) = *(const f32x4*)(Ks + (size_t)key * 256 + h * 64 + d4);
        *(LAS f32x4*)(Vf + key * 68 + d4) = *(const f32x4*)(Vs + (size_t)key * 256 + h * 64 + d4); }
    __syncthreads();
    {
        const int qi = tid >> 2, part = tid & 3; const int qrow = r0 + (qi < Lq ? qi : Lq - 1);
        f32x4 q[16], o[16];
#pragma unroll
        for (int j = 0; j < 8; ++j) { const u32x4 w = *(const u32x4*)(QC + (size_t)qrow * 256 + h * 64 + j * 8);
            q[2 * j] = (f32x4){bflo(w.x), bfhi(w.x), bflo(w.y), bfhi(w.y)}; q[2 * j + 1] = (f32x4){bflo(w.z), bfhi(w.z), bflo(w.w), bfhi(w.w)}; }
#pragma unroll
        for (int j = 0; j < 16; ++j) o[j] = (f32x4){0.f, 0.f, 0.f, 0.f};
        float m = -3.0e38f, l = 0.f;
#pragma unroll 1
        for (int kk = 0; kk < 64; ++kk) {
            const LAS float* kp = Kf + (kk * 4 + part) * 68; const LAS float* vp = Vf + (kk * 4 + part) * 68;
            f32x4 acc = (f32x4){0.f, 0.f, 0.f, 0.f};
#pragma unroll
            for (int j = 0; j < 16; ++j) acc += q[j] * *(const LAS f32x4*)(kp + 4 * j);
            const float s = (acc[0] + acc[1]) + (acc[2] + acc[3]);
            const float mn = fmaxf(m, s), sc = __expf(m - mn), p = __expf(s - mn);
            l = l * sc + p; m = mn;
#pragma unroll
            for (int j = 0; j < 16; ++j) o[j] = o[j] * sc + *(const LAS f32x4*)(vp + 4 * j) * p;
        }
#pragma unroll
        for (int off = 1; off < 4; off <<= 1) {
            const float m2 = __shfl_xor(m, off), l2 = __shfl_xor(l, off); const float mn = fmaxf(m, m2), a1 = __expf(m - mn), a2 = __expf(m2 - mn);
            l = l * a1 + l2 * a2; m = mn;
#pragma unroll
            for (int j = 0; j < 16; ++j) { f32x4 o2; o2[0] = __shfl_xor(o[j][0], off); o2[1] = __shfl_xor(o[j][1], off); o2[2] = __shfl_xor(o[j][2], off); o2[3] = __shfl_xor(o[j][3], off); o[j] = o[j] * a1 + o2 * a2; }
        }
        if (part == 0 && qi < Lq) { const float inv = 1.0f / l; bf16_t* dst = YC + (size_t)(r0 + qi) * 1024 + 768 + h * 64;
#pragma unroll
            for (int j = 0; j < 16; ++j) *(u32x2*)(dst + 4 * j) = pk4(o[j] * inv); }
    }
    __syncthreads();
}

__device__ __forceinline__ void pool_unit(const Ctx& C, const Args& a, int unit) {
    const float* UA = (const float*)(a.ws + WS_UA); bf16_t* YC = (bf16_t*)(a.ws + WS_XH);
    const int tid = fresh_tid(); const int c = tid & 255, half = tid >> 8, g = c >> 6, wn = 2 << g;
    for (int i = 0; i < 32; ++i) {
        const int row = unit * 64 + half * 32 + i;
        const float u = UA[(size_t)row * 256 + c]; float s = u, cnt;
        if (row < MP) {
            const int t = row & (SEQ - 1); const int n = t + 1 < wn ? t + 1 : wn; cnt = (float)n;
            for (int k = 1; k < n; ++k) s += UA[(size_t)(row - k) * 256 + c];
            if (t >= SEQ - 15) a.out[O_POOLP + ((size_t)(row >> 11) * 15 + (t - (SEQ - 15))) * 256 + c] = u;
        } else {
            const int j = row & 3, bb = (row - MP) >> 2; cnt = (float)wn;
            const float* sp = a.in[I_SPOOL] + (size_t)bb * 15 * 256 + c;
            for (int k = 1; k < wn; ++k) { const int p = j - k; s += p >= 0 ? UA[(size_t)(row - k) * 256 + c] : sp[(size_t)(15 + p) * 256]; }
            float* po = a.out + O_POOLS + (size_t)bb * 15 * 256 + c;
            po[(size_t)(11 + j) * 256] = u;
            if (j == 0) for (int k = 0; k < 11; ++k) po[(size_t)k * 256] = sp[(size_t)(k + 4) * 256];
        }
        YC[(size_t)row * 1024 + c] = f2bf(s / cnt - u);
    }
}

__device__ __forceinline__ int fetch_unit(const Ctx& C, unsigned* ctr, volatile LAS int* slot) {
    __syncthreads();
    if (fresh_tid() == 0) *slot = (int)atomicAdd(ctr, 1u);
    __syncthreads();
    return *slot;
}

__device__ __forceinline__ void ln_row(const float* src, bf16_t* oh, float* of, const float* g, const float* bta, int lane) {
    f32x4 v[4]; float s = 0.f;
#pragma unroll
    for (int j = 0; j < 4; ++j) { v[j] = *(const f32x4*)(src + 4 * lane + 256 * j); s += (v[j][0] + v[j][1]) + (v[j][2] + v[j][3]); }
    const float mean = wave_sum(s) * (1.f / 1024.f); float s2 = 0.f;
#pragma unroll
    for (int j = 0; j < 4; ++j) { v[j] = v[j] - mean; s2 += (v[j][0] * v[j][0] + v[j][1] * v[j][1]) + (v[j][2] * v[j][2] + v[j][3] * v[j][3]); }
    const float rstd = 1.f / sqrtf(wave_sum(s2) * (1.f / 1024.f) + LN_EPS);
#pragma unroll
    for (int j = 0; j < 4; ++j) { const f32x4 gg = *(const f32x4*)(g + 4 * lane + 256 * j), bb = *(const f32x4*)(bta + 4 * lane + 256 * j); const f32x4 o = v[j] * rstd * gg + bb;
        if (oh) *(u32x2*)(oh + 4 * lane + 256 * j) = pk4(o); else *(f32x4*)(of + 4 * lane + 256 * j) = o; }
}

#define XB_TMO      128
#define XB_XCNT(j)  (256  + 64 * (j))
#define XB_XSUB(j)  (1280 + 64 * (j))
#define XB_XGEN(j)  (2304 + 64 * (j))
#define XB_TOP      3328
#define XB_TOPGEN   3392
#define XCD_BAR_WORDS 3456
#define XB_SPIN_CAP (1u << 18)

__device__ __forceinline__ unsigned xb_ld(unsigned* p)              { return __hip_atomic_load(p, __ATOMIC_RELAXED, __HIP_MEMORY_SCOPE_AGENT); }
__device__ __forceinline__ unsigned xb_add(unsigned* p, unsigned v) { return __hip_atomic_fetch_add(p, v, __ATOMIC_RELAXED, __HIP_MEMORY_SCOPE_AGENT); }
__device__ __forceinline__ unsigned xb_xcc_id() { return (unsigned)__builtin_amdgcn_s_getreg((3 << 11) | 20) & 0xFu; }
#define XB_SPIN(cond, bar) do { unsigned _sp = 0; while (cond) { __builtin_amdgcn_s_sleep(1); \
    if ((++_sp & 255u) == 0u) { if (xb_ld(&(bar)[XB_TMO])) break; if (_sp > XB_SPIN_CAP) { atomicAdd(&(bar)[XB_TMO], 1u); break; } } } } while (0)

struct XcdBarrier {
    unsigned* bar; unsigned x;
    volatile LAS unsigned* st;
};

__device__ __forceinline__ XcdBarrier xcd_barrier_post(unsigned* bar, volatile LAS unsigned* st) {
    XcdBarrier b; b.bar = bar; b.x = xb_xcc_id(); b.st = st;
    if (threadIdx.x == 0) (void)xb_add(&bar[XB_XCNT(b.x)], 1u);
    return b;
}
__device__ __forceinline__ void xcd_barrier_complete(unsigned* bar, unsigned x, unsigned& nloc, unsigned& nx) {
    const unsigned G = gridDim.x * gridDim.y * gridDim.z;
    unsigned sum, cnt, mine, sp = 0u;
    for (;;) {
        sum = 0u; cnt = 0u; mine = 0u;
#pragma unroll
        for (unsigned j = 0; j < 16; ++j) { const unsigned c = xb_ld(&bar[XB_XCNT(j)]); sum += c; cnt += (c > 0u) ? 1u : 0u; mine = (j == x) ? c : mine; }
        if (sum == G) break;
        __builtin_amdgcn_s_sleep(1);
        if ((++sp & 255u) == 0u) { if (xb_ld(&bar[XB_TMO])) break; if (sp > XB_SPIN_CAP) { atomicAdd(&bar[XB_TMO], 1u); break; } }
    }
    nloc = mine > 0u ? mine : 1u; nx = cnt > 0u ? cnt : 1u;
}

__device__ __forceinline__ void xcd_barrier(const XcdBarrier& b) {
    asm volatile("s_waitcnt vmcnt(0)" ::: "memory");
    __syncthreads();
    if (threadIdx.x == 0) {
        unsigned* bar = b.bar;
        __builtin_amdgcn_s_waitcnt(0);
        unsigned nloc = b.st[0], nx = b.st[1];
        if (nloc == 0u) { xcd_barrier_complete(bar, b.x, nloc, nx); b.st[0] = nloc; b.st[1] = nx; }
        const unsigned old = xb_add(&bar[XB_XSUB(b.x)], 1u);
        const unsigned gen = old / nloc;
        if (old + 1u == (gen + 1u) * nloc) {
            __builtin_amdgcn_fence(__ATOMIC_RELEASE, "");
            asm volatile("s_waitcnt vmcnt(0)" ::: "memory");
            const unsigned og = xb_add(&bar[XB_TOP], 1u);
            const unsigned tg = og / nx;
            if (og + 1u == (tg + 1u) * nx) xb_add(&bar[XB_TOPGEN], 1u);
            else XB_SPIN(xb_ld(&bar[XB_TOPGEN]) == tg, bar);
            __builtin_amdgcn_fence(__ATOMIC_ACQUIRE, "");
            xb_add(&bar[XB_XGEN(b.x)], 1u);
            asm volatile("s_waitcnt vmcnt(0)" ::: "memory");
        } else {
            XB_SPIN(xb_ld(&bar[XB_XGEN(b.x)]) == gen, bar);
            __builtin_amdgcn_fence(__ATOMIC_ACQUIRE, "");
            asm volatile("s_waitcnt vmcnt(0)" ::: "memory");
        }
    }
    __syncthreads();
}

__device__ __forceinline__ constexpr int in_size_of(int k) {
    return k == 0 ? 16777216 : k == 1 ? 524288 : k == 2 ? 491520 : k == 3 ? 8388608 : k == 4 ? 720896 : k == 5 ? 8388608 : k == 6 ? 8388608 : k == 7 ? 2097152 : k == 8 ? 1024 : k == 9 ? 5767168 :
           k == 10 ? 16384 : k == 11 ? 256 : k == 12 ? 512 : k == 13 ? 262144 : k == 14 ? 262144 : k == 15 ? 262144 : k == 16 ? 524288 : k == 17 ? 262144 : k == 18 ? 1048576 : k == 19 ? 1024 : k == 20 ? 1024 :
           k == 21 ? 2883584 : k == 22 ? 2883584 : k == 23 ? 8448 : k == 24 ? 2816 : k == 25 ? 2883584 : 1024;
}
__global__ void __launch_bounds__(512, 2) fwd_kernel(Args a) {
    extern __shared__ __attribute__((aligned(16))) unsigned char lds_raw[];
    cg::grid_group grid = cg::this_grid();
    Ctx C; C.lds = (LAS unsigned char*)lds_raw; C.wave = __builtin_amdgcn_readfirstlane((int)threadIdx.x >> 6); C.G = gridDim.x; C.bid = blockIdx.x;
    unsigned char* ws = a.ws;
    unsigned* ctl = (unsigned*)(ws + WS_CTL);
    const int gw = C.bid * 8 + C.wave, NGW = C.G * 8;
    const size_t GT = (size_t)C.G * 512;
    float* YR = a.out + O_Y;
    volatile LAS unsigned* bst = (volatile LAS unsigned*)(C.lds + LDS_BYTES - 32);
    if (threadIdx.x < 2) bst[threadIdx.x] = 0u;
    __syncthreads();
    XcdBarrier bar = xcd_barrier_post(ctl + 1024, bst);
    {
        const unsigned xcc = xb_xcc_id() & 7u; volatile LAS int* rk = (volatile LAS int*)(C.lds + LDS_BYTES - 16);
        if (threadIdx.x == 0) rk[0] = (int)atomicAdd(ctl + 600 + xcc, 1u);
        __syncthreads(); C.xcd = (int)xcc; C.rank = __builtin_amdgcn_readfirstlane(rk[0]);
    }
    grid.sync();
#define GRID_BAR() xcd_barrier(bar)
    C.nloc = __builtin_amdgcn_readfirstlane((int)__hip_atomic_load(ctl + 600 + C.xcd, __ATOMIC_RELAXED, __HIP_MEMORY_SCOPE_AGENT));

    p0_prep(C, a);
    GRID_BAR();
    if (a.stop == 0) return;

    {
        pg8::Gemm g{(const bf16_t*)(ws + WS_XH), (const bf16_t*)(ws + WS_WIN), MT, INC, 1024, 1024}; pg8::XcdOrder S; S.init(MT, INC, C.G, C.bid); S.own(C.xcd, C.rank, C.nloc);
        pg8::EpiIn E{(float*)(ws + WS_UA), (bf16_t*)(a.out + OY_Q), a.out + OY_LF, (bf16_t*)(a.out + OY_KK), (bf16_t*)(ws + WS_V), (bf16_t*)(ws + WS_G), (bf16_t*)(ws + WS_QC), (bf16_t*)(ws + WS_GATE), (const float*)(ws + WS_LBT)};
        pg8::gemm_phase<pg8::EpiIn, pg8::XcdOrder, true, true>(C.lds, g, S, E);
        pg8::Gemm g2{(const bf16_t*)(ws + WS_MEMH), (const bf16_t*)(ws + WS_WMEM), 2048, 512, 1024, 1024}; pg8::XcdOrder S2; S2.init(2048, 512, C.G, C.bid); S2.own(C.xcd, C.rank, C.nloc); S2.r = (S2.r + 2) % S2.nloc;
        pg8::EpiMem E2{a.out + O_MEMK, a.out + O_MEMV};
        pg8::gemm_phase<pg8::EpiMem, pg8::XcdOrder, true, true>(C.lds, g2, S2, E2);
    }
    GRID_BAR();
    if (a.stop == 1) {
        const float* UA = (const float*)(ws + WS_UA); const float* LF = a.out + OY_LF; const bf16_t* Q = (const bf16_t*)(a.out + OY_Q); const bf16_t* KK = (const bf16_t*)(a.out + OY_KK);
        const bf16_t* V = (const bf16_t*)(ws + WS_V); const bf16_t* G = (const bf16_t*)(ws + WS_G); const bf16_t* QC = (const bf16_t*)(ws + WS_QC); const bf16_t* GT_ = (const bf16_t*)(ws + WS_GATE);
        float* D = a.out + O_HGS; const size_t gt = (size_t)C.bid * 512 + fresh_tid();
        for (size_t i = gt; i < (size_t)MT * 256; i += GT) { const size_t r = i >> 8; const int c = (int)(i & 255);
            float s = UA[r * 256 + c] + bf2f(QC[r * 256 + c]);
            for (int k = c; k < 512; k += 256) s += LF[r * 512 + k] + bf2f(Q[r * 512 + k]) + bf2f(KK[r * 512 + k]) + bf2f(V[r * 512 + k]) + bf2f(G[r * 512 + k]);
            for (int k = c; k < 3072; k += 256) s += bf2f(GT_[r * 3072 + k]);
            D[i] = s; }
        return;
    }

    {
        const int ox = C.xcd, orank = C.rank;
        if (orank < 16) hgrn_prompt_unit(C, a, ox * 16 + orank);
        volatile LAS int* slot = (volatile LAS int*)(C.lds + LDS_BYTES - 64);
        const int nsamp = ox < 2 ? 256 : 0, ntot = 2 * nsamp + 64 + 32 + (ox < 2 ? 4 : 0);
        for (;;) {
            int u = fetch_unit(C, ctl + 64 * (1 + ox), slot);
            if (u >= ntot) break;
            if (u < nsamp) { attn_unit(C, a, 512 + ox * 256 + u); continue; }
            u -= nsamp;
            if (u < nsamp) { hgrn_sample_unit(C, a, ox * 256 + u); continue; }
            u -= nsamp;
            if (u < 64) { attn_unit(C, a, ox * 64 + u); continue; }
            u -= 64;
            if (u < 32) pool_unit(C, a, ox * 32 + u); else pool_unit(C, a, 256 + ox * 4 + (u - 32));
        }
    }
    GRID_BAR();
    if (a.stop == 2) {
        const float* OB = (const float*)(ws + WS_OB); const bf16_t* YC = (const bf16_t*)(ws + WS_XH); const size_t gt = (size_t)C.bid * 512 + fresh_tid();
        for (size_t i = gt; i < (size_t)MT * 1024; i += GT) { const size_t r = i >> 10; const int c = (int)(i & 1023);
            YR[i] = c < 512 ? OB[r * 512 + c] : (c < 768 ? bf2f(YC[r * 1024 + c - 512]) : bf2f(YC[r * 1024 + c])); }
        return;
    }

    {
        const float* OB = (const float*)(ws + WS_OB); const bf16_t* G = (const bf16_t*)(ws + WS_G); bf16_t* YC = (bf16_t*)(ws + WS_XH); const float* gn = a.in[I_HGG];
        const int lane = fresh_tid() & 63; const int ox = C.xcd, orank = C.rank, onloc = C.nloc, onr = own_nrows(ox);
        for (int it = orank * 8 + C.wave; it < onr * 4; it += onloc * 8) {
            const int row = own_row(ox, it >> 2), h = it & 3; const size_t idx = (size_t)row * 512 + h * 128 + 2 * lane;
            const f32x2 o = *(const f32x2*)(OB + idx); const float ss = wave_sum(o[0] * o[0] + o[1] * o[1]);
            const float r = 1.0f / sqrtf(ss * (1.f / 128.f) + RMS_EPS);
            const unsigned gr = *(const unsigned*)(G + idx); const f32x2 gg = *(const f32x2*)(gn + h * 128 + 2 * lane);
            *(unsigned*)(YC + (size_t)row * 1024 + 256 + h * 128 + 2 * lane) = cvt_pk(o[0] * r * gg[0] * bflo(gr), o[1] * r * gg[1] * bfhi(gr));
        }
    }
    GRID_BAR();
    if (a.stop == 3) {
        const bf16_t* YC = (const bf16_t*)(ws + WS_XH); const size_t gt = (size_t)C.bid * 512 + fresh_tid();
        for (size_t i = gt; i < (size_t)MT * 1024; i += GT) YR[i] = bf2f(YC[i]);
        return;
    }

    {
        const bf16_t* YC = (const bf16_t*)(ws + WS_XH); const bf16_t* WB = (const bf16_t*)(ws + WS_WBR); const bf16_t* GATE = (const bf16_t*)(ws + WS_GATE);
        float* MF = YR; bf16_t* MH = (bf16_t*)(ws + WS_OB);
        pg8::XcdOrder S; S.init(MT, 1024, C.G, C.bid); S.own(C.xcd, C.rank, C.nloc);
        { pg8::Gemm g{YC, WB, MT, 1024, 256, 1024}; pg8::EpiBr<0> E{GATE, MF, MH}; pg8::gemm_phase<pg8::EpiBr<0>, pg8::XcdOrder, true, true>(C.lds, g, S, E); }
        { pg8::Gemm g{YC + 256, WB + 256, MT, 1024, 512, 1024}; pg8::EpiBr<1> E{GATE, MF, MH}; pg8::gemm_phase<pg8::EpiBr<1>, pg8::XcdOrder, true, true>(C.lds, g, S, E); }
        { pg8::Gemm g{YC + 768, WB + 768, MT, 1024, 256, 1024}; pg8::EpiBr<2> E{GATE, MF, MH}; pg8::gemm_phase<pg8::EpiBr<2>, pg8::XcdOrder, true, true>(C.lds, g, S, E); }
    }
    GRID_BAR();
    if (a.stop == 4) return;

    {
        pg8::Gemm g{(const bf16_t*)(ws + WS_OB), (const bf16_t*)(ws + WS_WOUT), MT, 1024, 1024, 1024}; pg8::XcdOrder S; S.init(MT, 1024, C.G, C.bid); S.own(C.xcd, C.rank, C.nloc);
        pg8::EpiOut E{a.in[I_XP], a.in[I_XS], YR};
        pg8::gemm_phase<pg8::EpiOut, pg8::XcdOrder, true, true>(C.lds, g, S, E);
    }
    GRID_BAR();
    if (a.stop == 5) return;

    { const int lane = fresh_tid() & 63; const int ox = C.xcd, orank = C.rank, onloc = C.nloc, onr = own_nrows(ox);
      for (int l = orank * 8 + C.wave; l < onr; l += onloc * 8) { const int row = own_row(ox, l); ln_row(YR + (size_t)row * 1024, (bf16_t*)(ws + WS_XH) + (size_t)row * 1024, nullptr, a.in[I_LN1G], a.in[I_LN1B], lane); } }
    GRID_BAR();
    if (a.stop == 6) {
        const bf16_t* YC = (const bf16_t*)(ws + WS_XH); const size_t gt = (size_t)C.bid * 512 + fresh_tid();
        for (size_t i = gt; i < (size_t)MT * 1024; i += GT) YR[i] = bf2f(YC[i]);
        return;
    }

    {
        pg8::Gemm g{(const bf16_t*)(ws + WS_XH), (const bf16_t*)(ws + WS_WGU), MT, 2 * DFF, 1024, 1024}; pg8::XcdOrder S; S.init(MT, 2 * DFF, C.G, C.bid); S.own(C.xcd, C.rank, C.nloc);
        pg8::EpiFfn1 E{(bf16_t*)(ws + WS_A16), (bf16_t*)(ws + WS_U16), a.out + O_CONVP, a.out + O_CONVS};
        pg8::gemm_phase<pg8::EpiFfn1, pg8::XcdOrder, true, true>(C.lds, g, S, E);
    }
    GRID_BAR();
    if (a.stop == 7) {
        const bf16_t* A_ = (const bf16_t*)(ws + WS_A16); const bf16_t* U_ = (const bf16_t*)(ws + WS_U16); const size_t gt = (size_t)C.bid * 512 + fresh_tid();
        for (size_t i = gt; i < (size_t)MT * 1024; i += GT) { const size_t r = i >> 10; const int c = (int)(i & 1023); float s = 0.f; for (int k = c; k < DFF; k += 1024) s += bf2f(A_[r * DFF + k]) + 2.0f * bf2f(U_[r * DFF + k]); YR[i] = s; }
        return;
    }

    {
        const bf16_t* A16 = (const bf16_t*)(ws + WS_A16); bf16_t* U16 = (bf16_t*)(ws + WS_U16);
        const float* cw = a.in[I_CONVW]; const float* cb = a.in[I_CONVB]; const float* sc = a.in[I_SCONV];
        const int ox = C.xcd, orank = C.rank, onloc = C.nloc, onrows = 2048 + (ox < 2 ? 256 : 0);
        for (int i = orank * 512 + fresh_tid(); i < onrows * (DFF / 8); i += onloc * 512) {
            const int l = i / (DFF / 8), c8 = (i % (DFF / 8)) * 8; const int row = l < 2048 ? ox * 2048 + l : MP + ox * 256 + (l - 2048);
            const u32x4 a2 = *(const u32x4*)(A16 + (size_t)row * DFF + c8); const u32x4 uu = *(const u32x4*)(U16 + (size_t)row * DFF + c8);
            float x0[8], x1[8];
            if (row < MP) {
                const int t = row & (SEQ - 1);
                u32x4 p1 = (u32x4){0u, 0u, 0u, 0u}, p0 = p1;
                if (t >= 1) p1 = *(const u32x4*)(A16 + (size_t)(row - 1) * DFF + c8);
                if (t >= 2) p0 = *(const u32x4*)(A16 + (size_t)(row - 2) * DFF + c8);
                _Pragma("unroll") for (int e = 0; e < 4; ++e) { x1[2 * e] = bflo(p1[e]); x1[2 * e + 1] = bfhi(p1[e]); x0[2 * e] = bflo(p0[e]); x0[2 * e + 1] = bfhi(p0[e]); }
            } else {
                const int j = row & 3, bb = (row - MP) >> 2; const float* sb = sc + (size_t)bb * 2 * DFF + c8;
                if (j >= 1) { const u32x4 p1 = *(const u32x4*)(A16 + (size_t)(row - 1) * DFF + c8); _Pragma("unroll") for (int e = 0; e < 4; ++e) { x1[2 * e] = bflo(p1[e]); x1[2 * e + 1] = bfhi(p1[e]); } }
                else _Pragma("unroll") for (int e = 0; e < 8; ++e) x1[e] = sb[DFF + e];
                if (j >= 2) { const u32x4 p0 = *(const u32x4*)(A16 + (size_t)(row - 2) * DFF + c8); _Pragma("unroll") for (int e = 0; e < 4; ++e) { x0[2 * e] = bflo(p0[e]); x0[2 * e + 1] = bfhi(p0[e]); } }
                else _Pragma("unroll") for (int e = 0; e < 8; ++e) x0[e] = sb[(size_t)j * DFF + e];
            }
            float r[8];
#pragma unroll
            for (int e = 0; e < 8; ++e) {
                const float x2 = (e & 1) ? bfhi(a2[e >> 1]) : bflo(a2[e >> 1]); const float uv = (e & 1) ? bfhi(uu[e >> 1]) : bflo(uu[e >> 1]);
                const float cv = cb[c8 + e] + cw[c8 + e] * x0[e] + cw[DFF + c8 + e] * x1[e] + cw[2 * DFF + c8 + e] * x2;
                r[e] = 0.5f * cv * (1.0f + erff(cv * 0.70710678118654752f)) * uv;
            }
            u32x4 o; o.x = cvt_pk(r[0], r[1]); o.y = cvt_pk(r[2], r[3]); o.z = cvt_pk(r[4], r[5]); o.w = cvt_pk(r[6], r[7]);
            *(u32x4*)(U16 + (size_t)row * DFF + c8) = o;
        }
    }
    GRID_BAR();
    if (a.stop == 8) {
        const bf16_t* U_ = (const bf16_t*)(ws + WS_U16); const size_t gt = (size_t)C.bid * 512 + fresh_tid();
        for (size_t i = gt; i < (size_t)MT * 1024; i += GT) { const size_t r = i >> 10; const int c = (int)(i & 1023); float s = 0.f; for (int k = c; k < DFF; k += 1024) s += bf2f(U_[r * DFF + k]); YR[i] = s; }
        return;
    }

    {
        pg8::Gemm g{(const bf16_t*)(ws + WS_U16), (const bf16_t*)(ws + WS_WDOWN), MT, 1024, DFF, DFF}; pg8::XcdOrder S; S.init(MT, 1024, C.G, C.bid); S.own(C.xcd, C.rank, C.nloc);
        pg8::EpiFfn2 E{(const bf16_t*)(ws + WS_XH), YR};
        pg8::gemm_phase<pg8::EpiFfn2, pg8::XcdOrder, true, true>(C.lds, g, S, E);
    }
    GRID_BAR();
    if (a.stop == 9) return;

    { const int lane = fresh_tid() & 63; const int ox = C.xcd, orank = C.rank, onloc = C.nloc, onr = own_nrows(ox);
      for (int l = orank * 8 + C.wave; l < onr; l += onloc * 8) { const int row = own_row(ox, l); ln_row(YR + (size_t)row * 1024, nullptr, YR + (size_t)row * 1024, a.in[I_LN2G], a.in[I_LN2B], lane); } }
}

extern "C" void kernel_launch(void* const* d_in, const int* in_sizes, int n_in, void* d_out, int out_size, void* d_ws, size_t ws_size, hipStream_t stream) {
    static int grid = 0;
    if (grid == 0) {
        if (n_in != 28 || (size_t)out_size != O_END || ws_size < WS_END) { fprintf(stderr, "kernel_launch: unexpected problem: n_in %d out %d ws %zu\n", n_in, out_size, ws_size); grid = -1; return; }
        int dev = 0, cus = 0, per_cu = 0;
        (void)hipGetDevice(&dev);
        (void)hipDeviceGetAttribute(&cus, hipDeviceAttributeMultiprocessorCount, dev);
        (void)hipFuncSetAttribute((const void*)fwd_kernel, hipFuncAttributeMaxDynamicSharedMemorySize, LDS_BYTES);
        (void)hipOccupancyMaxActiveBlocksPerMultiprocessor(&per_cu, (const void*)fwd_kernel, 512, LDS_BYTES);
        if (per_cu < 1) per_cu = 1;
        grid = cus * per_cu;
        fprintf(stderr, "kernel_launch: grid %d (cus %d x %d) ws %zu\n", grid, cus, per_cu, ws_size);
    }
    if (grid < 0) return;
    (void)hipMemsetAsync((char*)d_ws + WS_CTL, 0, CTL_BYTES, stream);
    Args a{};
    for (int i = 0; i < 28; ++i) a.in[i] = (const float*)d_in[i];
    a.out = (float*)d_out; a.ws = (unsigned char*)d_ws; a.stop = STOP_RT; a.pad = P2_MASK;
    void* args[] = {&a};
    hipError_t e = hipLaunchCooperativeKernel((const void*)fwd_kernel, dim3(grid), dim3(512), args, LDS_BYTES, stream);
    if (e != hipSuccess) fprintf(stderr, "kernel_launch: cooperative launch failed: %s (grid %d)\n", hipGetErrorString(e), grid);
}
```

```cpp
#include <hip/hip_runtime.h>
#include <hip/hip_cooperative_groups.h>
#include <cstdio>
#include <cstdint>
namespace cg = cooperative_groups;

constexpr int DM = 1024, NB = 8, SEQ = 2048, DB = 128, DSEQ = 4;
constexpr int MP = NB * SEQ, MS = DB * DSEQ, MT = MP + MS;
constexpr int INC = 5632, DFF = 2816, MEML = 256;
constexpr float DN_ALPHA = 1.189207115002721f;
constexpr float LN_EPS = 1e-5f, RMS_EPS = 1e-6f;
constexpr size_t O_Y = 0, O_POOLP = 17301504, O_HGP = 17332224, O_CONVP = 17856512, O_MEMK = 17901568, O_MEMV = 18425856,
                 O_POOLS = 18950144, O_HGS = 19441664, O_CONVS = 27830272, O_END = 28551168;
constexpr size_t OY_LF = 0, OY_Q = 8650752, OY_KK = 12976128;
constexpr size_t MiB = 1u << 20;
constexpr size_t WS_CTL = 0, CTL_BYTES = 32768, WS_LBT = 65536;
constexpr size_t WS_WGU = 1 * MiB, WS_WDOWN = 12 * MiB, WS_WOUT = 18 * MiB, WS_WBR = 20 * MiB;
constexpr size_t WS_XH = 22 * MiB;
constexpr size_t WS_GATE = 55 * MiB;
constexpr size_t WS_UA = 154 * MiB;
constexpr size_t WS_V = WS_UA + 17301504, WS_G = WS_V + 17301504, WS_QC = WS_G + 17301504;
constexpr size_t WS_WIN = WS_QC + 8650752;
constexpr size_t WS_WMEM = WS_WIN + 11534336, WS_MEMH = WS_WMEM + 1048576;
constexpr size_t WS_OB = WS_WIN;
constexpr size_t WS_A16 = 55 * MiB, WS_U16 = 146 * MiB;
constexpr size_t WS_END = 256 * MiB;
static_assert(WS_MEMH + 4194304 <= WS_END && WS_OB + 34603008 <= WS_END && WS_U16 + 95158272 <= WS_END && WS_A16 + 95158272 <= WS_U16, "ws map");
static_assert(WS_XH + 34603008 <= WS_GATE && WS_GATE + 103809024 <= WS_UA, "ws map 2");
constexpr int LDS_BYTES = 147456;

#define LAS __attribute__((address_space(3)))
typedef unsigned short bf16_t;
typedef short bf16x8 __attribute__((ext_vector_type(8)));
typedef float f32x4 __attribute__((ext_vector_type(4)));
typedef float f32x2 __attribute__((ext_vector_type(2)));
typedef unsigned u32x4 __attribute__((ext_vector_type(4)));
typedef unsigned u32x2 __attribute__((ext_vector_type(2)));

__device__ __forceinline__ unsigned cvt_pk(float lo, float hi) { unsigned r; asm volatile("v_cvt_pk_bf16_f32 %0, %1, %2" : "=v"(r) : "v"(lo), "v"(hi)); return r; }
__device__ __forceinline__ bf16_t f2bf(float f) { return (bf16_t)(cvt_pk(f, 0.f) & 0xffffu); }
__device__ __forceinline__ float bf2f(unsigned h) { return __uint_as_float(h << 16); }
__device__ __forceinline__ float bflo(unsigned w) { return __uint_as_float(w << 16); }
__device__ __forceinline__ float bfhi(unsigned w) { return __uint_as_float(w & 0xffff0000u); }
__device__ __forceinline__ u32x2 pk4(f32x4 v) { u32x2 r; r.x = cvt_pk(v[0], v[1]); r.y = cvt_pk(v[2], v[3]); return r; }
__device__ __forceinline__ f32x4 unpk4(u32x2 w) { return (f32x4){bflo(w.x), bfhi(w.x), bflo(w.y), bfhi(w.y)}; }
__device__ __forceinline__ void st8_coh(void* p, u32x2 v) { __hip_atomic_store((unsigned long long*)p, ((unsigned long long)v.y << 32) | v.x, __ATOMIC_RELAXED, __HIP_MEMORY_SCOPE_SYSTEM); }
__device__ __forceinline__ float sigmoidf_(float x) { return 1.0f / (1.0f + __expf(-x)); }
__device__ __forceinline__ float wave_sum(float v) {
#pragma unroll
    for (int o = 1; o < 64; o <<= 1) v += __shfl_xor(v, o);
    return v;
}

struct Args {
    const float* in[28];
    float* out; unsigned char* ws;
    int stop, pad;
};
#ifndef STOP_RT
#define STOP_RT 99
#endif
#ifndef REP_MASK
#define REP_MASK 0
#endif
enum { I_XP = 0, I_XS, I_SPOOL, I_SHG, I_SCONV, I_CK, I_CV, I_MEMP, I_LB, I_WIN, I_WGRP, I_PSCALE, I_HGG, I_WMK, I_WMV, I_WBP, I_WBH, I_WBM,
       I_WOUT, I_LN1G, I_LN1B, I_WGATE, I_WUP, I_CONVW, I_CONVB, I_WDOWN, I_LN2G, I_LN2B };

namespace pg8 {
#define PG8_LAS __attribute__((address_space(3)))
typedef unsigned short bf16_t;
typedef short bf16x8 __attribute__((ext_vector_type(8)));
typedef float f32x4 __attribute__((ext_vector_type(4)));
typedef unsigned u32x4 __attribute__((ext_vector_type(4)));
constexpr int BM = 256, BK = 64, HALF = 128, HTB = HALF * BK * 2  , STAGE_BYTES = 8 * HTB, NXCD = 8, WGM = 8;

__host__ __device__ __forceinline__ int lds_byte(int r, int c) { const int st = (r >> 4) * 2 + (c >> 5), rr = r & 15, cc = c & 31, ob = rr * 64 + cc * 2; return st * 1024 + (ob ^ (((ob >> 9) & 1) << 5)); }
__host__ __device__ __forceinline__ void stage_rc(int b, int& R, int& C) { const int st = b / 1024, sb = b % 1024, swz = sb ^ (((sb >> 9) & 1) << 5); R = (st >> 1) * 16 + swz / 64; C = (st & 1) * 32 + (swz % 64) / 2; }
__host__ __device__ __forceinline__ int perm32(int rho) { const int n = rho >> 4, i = rho & 15; return 8 * (i >> 2) + 4 * n + (i & 3); }

struct Unit { int pm, pn, k0, nt; };
struct Gemm { const bf16_t* A; const bf16_t* Bt; int M, N, K, ld; };

struct StaticOrder {
    int nM, nN, nwg, G, c;
    __host__ __device__ void init(int M, int N, int G_, int c_) { nM = M / BM; nN = N / BM; nwg = nM * nN; G = G_; c = c_; }
    __host__ __device__ bool next(int i, Unit& u) const {
        const long L = (long)i * G + c; if (L >= nwg) return false;
        int wgid = (int)L; { const int q = nwg / NXCD, r = nwg % NXCD, xcd = wgid % NXCD, off = wgid / NXCD; wgid = (xcd < r ? xcd * (q + 1) : r * (q + 1) + (xcd - r) * q) + off; }
        const int nig = WGM * nN, gid = wgid / nig, fm = gid * WGM, gsz = (nM - fm) < WGM ? (nM - fm) : WGM;
        u.pm = fm + ((wgid % nig) % gsz); u.pn = (wgid % nig) / gsz; u.k0 = 0; u.nt = 0; return true;
    }
    __device__ __forceinline__ void a_ready(const Unit&) const {}
    __device__ __forceinline__ void done(const Unit&) const {}
};

struct XcdOrder {
    int nN, nloc, x, r, npm, mode;
    __host__ __device__ void init(int M, int N, int G_, int c_) { nN = N / BM; nloc = G_ >> 3; x = c_ & 7; r = c_ >> 3; mode = (M == 2048) ? 1 : 0; npm = mode ? 1 : (8 + (x < 2 ? 1 : 0)); }
    __host__ __device__ void own(int x_, int r_, int nloc_) { x = x_; r = r_; nloc = nloc_; npm = mode ? 1 : (8 + (x < 2 ? 1 : 0)); }
    __host__ __device__ bool next(int i, Unit& u) const {
        const int idx = i * nloc + r; if (idx >= npm * nN) return false;
        const int k = idx % npm; u.pn = idx / npm; u.pm = mode ? x : (k < 8 ? x * 8 + k : 64 + x); u.k0 = 0; u.nt = 0; return true;
    }
    __device__ __forceinline__ void a_ready(const Unit&) const {}
    __device__ __forceinline__ void done(const Unit&) const {}
};

struct SplitOrder {
    StaticOrder P; int c, S, ntS;
    __host__ __device__ void init(int K, int G_, int c_, int S_) { P.init(16384, 1024, G_, c_); c = c_; S = S_; ntS = (K / S_) / BK; }
    __host__ __device__ bool next(int i, Unit& u) const {
        if (i == 0) return P.next(0, u);
        if (i == 1 && c < 8 * S) { const int rem = c % (4 * S); u.pm = 64 + c / (4 * S); u.pn = rem / S; u.k0 = (rem % S) * ntS * BK; u.nt = ntS; return true; }
        return false;
    }
    __device__ __forceinline__ void a_ready(const Unit&) const {}
    __device__ __forceinline__ void done(const Unit&) const {}
};

#define EPI_LOOP(...) \
    _Pragma("unroll") for (int ai = 0; ai < 2; ++ai) _Pragma("unroll") for (int m = 0; m < 4; ++m) { const int row = row0 + ai * 128 + m * 16; \
    _Pragma("unroll") for (int bj = 0; bj < 2; ++bj) _Pragma("unroll") for (int n = 0; n < 2; ++n) { const int col = col0 + bj * 128 + n * 16; const f32x4 v = acc[ai][bj][m][n]; __VA_ARGS__ } asm volatile("" ::: "memory"); }

struct EpiIn {
    static constexpr bool PERM = false, AFTER_DRAIN = false;
    float* UA; bf16_t* Q; float* LF; bf16_t* KK; bf16_t* V; bf16_t* G; bf16_t* QC; bf16_t* GATE; const float* lbl;
    __device__ __forceinline__ void operator()(const f32x4 (&acc)[2][2][4][2], const Unit& u, int wr, int wc, int fr, int fq) const {
        const int row0 = u.pm * BM + wr * 64 + fr, colt = u.pn * BM, col0 = colt + wc * 32 + 4 * fq;
        if (colt < 256) {
            EPI_LOOP( *(f32x4*)(UA + (size_t)row * 256 + col) = v; )
        } else if (colt < 768) {
            EPI_LOOP( f32x4 o; _Pragma("unroll") for (int e = 0; e < 4; ++e) o[e] = v[e] * sigmoidf_(v[e]); *(u32x2*)(Q + (size_t)row * 512 + (col - 256)) = pk4(o); )
        } else if (colt < 1280) {
            EPI_LOOP( f32x4 lf, kk; const f32x4 lb = *(const f32x4*)(lbl + (col - 768));
                _Pragma("unroll") for (int e = 0; e < 4; ++e) { const float s = sigmoidf_(v[e]); lf[e] = __logf(lb[e] + (1.0f - lb[e]) * s); kk[e] = (1.0f - lb[e]) * (1.0f - s); }
                *(f32x4*)(LF + (size_t)row * 512 + (col - 768)) = lf; *(u32x2*)(KK + (size_t)row * 512 + (col - 768)) = pk4(kk); )
        } else if (colt < 1792) {
            EPI_LOOP( *(u32x2*)(V + (size_t)row * 512 + (col - 1280)) = pk4(v); )
        } else if (colt < 2304) {
            EPI_LOOP( f32x4 o; _Pragma("unroll") for (int e = 0; e < 4; ++e) o[e] = v[e] * sigmoidf_(v[e]); *(u32x2*)(G + (size_t)row * 512 + (col - 1792)) = pk4(o); )
        } else if (colt < 2560) {
            EPI_LOOP( *(u32x2*)(QC + (size_t)row * 256 + (col - 2304)) = pk4(v * 0.125f); )
        } else {
            EPI_LOOP( f32x4 o; _Pragma("unroll") for (int e = 0; e < 4; ++e) o[e] = sigmoidf_(v[e]); *(u32x2*)(GATE + (size_t)row * 3072 + (col - 2560)) = pk4(o); )
        }
    }
};
struct EpiMem {
    static constexpr bool PERM = false, AFTER_DRAIN = false;
    float* KO; float* VO;
    __device__ __forceinline__ void operator()(const f32x4 (&acc)[2][2][4][2], const Unit& u, int wr, int wc, int fr, int fq) const {
        const int row0 = u.pm * BM + wr * 64 + fr, colt = u.pn * BM, col0 = wc * 32 + 4 * fq;
        float* O = colt == 0 ? KO : VO;
        EPI_LOOP( *(f32x4*)(O + (size_t)row * 256 + col) = v; )
    }
};
template <int J> struct EpiBr {
    static constexpr bool PERM = false, AFTER_DRAIN = false;
    const bf16_t* GATE; float* MF; bf16_t* MH;
    __device__ __forceinline__ void operator()(const f32x4 (&acc)[2][2][4][2], const Unit& u, int wr, int wc, int fr, int fq) const {
        const int row0 = u.pm * BM + wr * 64 + fr, col0 = u.pn * BM + wc * 32 + 4 * fq;
        EPI_LOOP( const f32x4 g = unpk4(*(const u32x2*)(GATE + (size_t)row * 3072 + J * 1024 + col)); f32x4 r = g * v; float* mp = MF + (size_t)row * 1024 + col;
            if (J > 0) r += *(const f32x4*)mp;
            if (J < 2) *(f32x4*)mp = r; else *(u32x2*)(MH + (size_t)row * 1024 + col) = pk4(r); )
    }
};
struct EpiOut {
    static constexpr bool PERM = false, AFTER_DRAIN = false;
    const float* xp; const float* xs; float* HP; float* PART;
    __device__ __forceinline__ void operator()(const f32x4 (&acc)[2][2][4][2], const Unit& u, int wr, int wc, int fr, int fq) const {
        const int row0 = u.pm * BM + wr * 64 + fr, col0 = u.pn * BM + wc * 32 + 4 * fq;
        const float* xb = (u.pm * BM < MP) ? xp : (xs - (size_t)MP * 1024);
        if (u.nt) {
            float* pp = PART + (size_t)(u.k0 / (u.nt * BK)) * (512 * 1024) - (size_t)MP * 1024;
            EPI_LOOP( *(f32x4*)(pp + (size_t)row * 1024 + col) = v; )
        } else {
            EPI_LOOP( const f32x4 x = *(const f32x4*)(xb + (size_t)row * 1024 + col); *(f32x4*)(HP + (size_t)row * 1024 + col) = x * DN_ALPHA + v; )
        }
    }
};
struct EpiFfn1 {
    static constexpr bool PERM = false, AFTER_DRAIN = false;
    bf16_t* A16; bf16_t* U16; float* convp; float* convs;
    __device__ __forceinline__ void operator()(const f32x4 (&acc)[2][2][4][2], const Unit& u, int wr, int wc, int fr, int fq) const {
        const int row0 = u.pm * BM + wr * 64 + fr, colt = u.pn * BM, col0 = colt + wc * 32 + 4 * fq;
        if (colt < DFF) {
            EPI_LOOP( *(u32x2*)(A16 + (size_t)row * DFF + col) = pk4(v);
                if (row < MP) { const int t = row & (SEQ - 1); if (t >= SEQ - 2) *(f32x4*)(convp + ((size_t)(row >> 11) * 2 + (t - (SEQ - 2))) * DFF + col) = v; }
                else { const int j = row & 3; if (j >= 2) *(f32x4*)(convs + ((size_t)((row - MP) >> 2) * 2 + (j - 2)) * DFF + col) = v; } )
        } else {
            EPI_LOOP( *(u32x2*)(U16 + (size_t)row * DFF + (col - DFF)) = pk4(v); )
        }
    }
};
struct EpiFfn2 {
    static constexpr bool PERM = false, AFTER_DRAIN = false;
    const bf16_t* H; float* YP; float* PART;
    __device__ __forceinline__ void operator()(const f32x4 (&acc)[2][2][4][2], const Unit& u, int wr, int wc, int fr, int fq) const {
        const int row0 = u.pm * BM + wr * 64 + fr, col0 = u.pn * BM + wc * 32 + 4 * fq;
        if (u.nt) {
            float* pp = PART + (size_t)(u.k0 / (u.nt * BK)) * (512 * 1024) - (size_t)MP * 1024;
            EPI_LOOP( *(f32x4*)(pp + (size_t)row * 1024 + col) = v; )
        } else {
            EPI_LOOP( const f32x4 h = unpk4(*(const u32x2*)(H + (size_t)row * 1024 + col)); *(f32x4*)(YP + (size_t)row * 1024 + col) = h * DN_ALPHA + v; )
        }
    }
};

template <class Epi, class Sched, bool ALIGN_EPI = false, bool SP2 = false>
__device__ __forceinline__ void gemm_phase(PG8_LAS unsigned char* lds, const Gemm g, const Sched& S, const Epi& E) {
    int tid_ = threadIdx.x; asm volatile("" : "+v"(tid_));
    const int tid = tid_, wid = __builtin_amdgcn_readfirstlane(tid >> 6), lane = tid & 63, wr = wid >> 2, wc = wid & 3, fr = lane & 15, fq = lane >> 4;
    const int K = g.ld, nt = g.K / BK;
    unsigned voffA[2], voffB[2];
#pragma unroll
    for (int i = 0; i < 2; ++i) { int R, C; stage_rc(tid * 16 + i * 8192, R, C); const int Rb = Epi::PERM ? ((R & ~31) + perm32(R & 31)) : R;
        voffA[i] = (unsigned)(R * K + C) * 2u; voffB[i] = (unsigned)(Rb * K + C) * 2u; }
    const size_t kstep = (size_t)(BK * 2);
    const size_t hstep = (size_t)HALF * K * 2;
    const size_t tstep = 2 * hstep;
    const unsigned ldsw = (unsigned)wid * 1024u;
    const int aoff = lds_byte(wr * 64 + fr, fq * 8), boff = lds_byte(wc * 32 + fr, fq * 8);
#define PG8_SA(b, h) (((b) * 2 + (h)) * HTB)
#define PG8_SB(b, h) ((4 + (b) * 2 + (h)) * HTB)
#define PG8_STAGE(bufoff, gbase, voff) do { _Pragma("unroll") for (int _i = 0; _i < 2; ++_i) \
        __builtin_amdgcn_global_load_lds((const unsigned*)((const char*)(gbase) + (voff)[_i]), (PG8_LAS unsigned*)(lds + (bufoff) + ldsw + _i * 8192), 16, 0, 0); } while (0)
#define PG8_LDA(dst, b, h) do { _Pragma("unroll") for (int m = 0; m < 4; ++m) _Pragma("unroll") for (int k = 0; k < 2; ++k) dst[m][k] = *(const PG8_LAS bf16x8*)(lds + PG8_SA(b, h) + aoff + m * 2048 + k * 1024); } while (0)
#define PG8_LDB(dst, b, h) do { _Pragma("unroll") for (int n = 0; n < 2; ++n) _Pragma("unroll") for (int k = 0; k < 2; ++k) dst[n][k] = *(const PG8_LAS bf16x8*)(lds + PG8_SB(b, h) + boff + n * 2048 + k * 1024); } while (0)
#define PG8_MMA(ai, bj, At, Bt) do { __builtin_amdgcn_s_setprio(1); _Pragma("unroll") for (int m = 0; m < 4; ++m) _Pragma("unroll") for (int n = 0; n < 2; ++n) _Pragma("unroll") for (int k = 0; k < 2; ++k) \
        acc[ai][bj][m][n] = __builtin_amdgcn_mfma_f32_16x16x32_bf16(Bt[n][k], At[m][k], acc[ai][bj][m][n], 0, 0, 0); __builtin_amdgcn_s_setprio(0); } while (0)
#define PG8_WAIT_V(n) asm volatile("s_waitcnt vmcnt(" #n ")" ::: "memory")
#define PG8_WAIT_L(n) asm volatile("s_waitcnt lgkmcnt(" #n ")" ::: "memory")
#define PG8_BAR __builtin_amdgcn_s_barrier()
#define PG8_SCHED __builtin_amdgcn_sched_barrier(0)
    Unit cur, nxt; int ui = 0;
    if (!S.next(0, cur)) return;
    f32x4 acc[2][2][4][2];
#pragma unroll
    for (int a = 0; a < 2; ++a)
#pragma unroll
        for (int b = 0; b < 2; ++b)
#pragma unroll
            for (int m = 0; m < 4; ++m)
#pragma unroll
                for (int n = 0; n < 2; ++n) acc[a][b][m][n] = (f32x4){0.f, 0.f, 0.f, 0.f};
    bf16x8 At[4][2], B0[2][2], B1[2][2];
    const char* cA = (const char*)g.A + (size_t)cur.pm * tstep + (size_t)cur.k0 * 2; const char* cB = (const char*)g.Bt + (size_t)cur.pn * tstep + (size_t)cur.k0 * 2;
    S.a_ready(cur);
    if constexpr (SP2) {
        PG8_STAGE(PG8_SB(0, 0), cB, voffB); PG8_STAGE(PG8_SB(0, 1), cB + hstep, voffB); PG8_STAGE(PG8_SA(0, 0), cA, voffA); PG8_STAGE(PG8_SA(0, 1), cA + hstep, voffA);
        if (wr == 1) PG8_BAR;
        PG8_WAIT_V(2); PG8_BAR;
        PG8_STAGE(PG8_SB(1, 0), cB + kstep, voffB); PG8_STAGE(PG8_SA(1, 0), cA + kstep, voffA); PG8_STAGE(PG8_SB(1, 1), cB + hstep + kstep, voffB);
        PG8_WAIT_V(6); PG8_BAR;
    } else {
        PG8_STAGE(PG8_SB(0, 0), cB, voffB); PG8_STAGE(PG8_SA(0, 0), cA, voffA); PG8_STAGE(PG8_SB(0, 1), cB + hstep, voffB); PG8_STAGE(PG8_SA(0, 1), cA + hstep, voffA);
        if (wr == 1) PG8_BAR;
        PG8_WAIT_V(4); PG8_BAR;
        PG8_STAGE(PG8_SB(1, 0), cB + kstep, voffB); PG8_STAGE(PG8_SA(1, 0), cA + kstep, voffA); PG8_STAGE(PG8_SB(1, 1), cB + hstep + kstep, voffB);
        PG8_WAIT_V(6); PG8_BAR;
    }
    for (;;) {
        const bool has_next = S.next(ui + 1, nxt);
        const char* nA = has_next ? (const char*)g.A + (size_t)nxt.pm * tstep + (size_t)nxt.k0 * 2 : cA; const char* nB = has_next ? (const char*)g.Bt + (size_t)nxt.pn * tstep + (size_t)nxt.k0 * 2 : cB;
        const int unt = cur.nt ? cur.nt : nt;
        for (int t = 0; t < unt; t += 2) {
            const bool last = (t == unt - 2);
            const char* a1 = cA + (size_t)(t + 1) * kstep;
            const char* a2 = last ? nA : cA + (size_t)(t + 2) * kstep; const char* b2 = last ? nB : cB + (size_t)(t + 2) * kstep;
            const char* a3 = a2 + kstep; const char* b3 = b2 + kstep;
            if (last && has_next) S.a_ready(nxt);
            if constexpr (SP2) {
            PG8_LDB(B0, 0, 0); PG8_LDB(B1, 0, 1); PG8_SCHED; PG8_LDA(At, 0, 0); PG8_STAGE(PG8_SA(1, 1), a1 + hstep, voffA);
            PG8_WAIT_V(8); PG8_WAIT_L(0); PG8_BAR; PG8_MMA(0, 0, At, B0); PG8_MMA(0, 1, At, B1); PG8_BAR; PG8_SCHED;
            PG8_LDA(At, 0, 1); PG8_STAGE(PG8_SB(0, 0), b2, voffB); PG8_STAGE(PG8_SB(0, 1), b2 + hstep, voffB); PG8_STAGE(PG8_SA(0, 0), a2, voffA);
            PG8_WAIT_V(8); PG8_WAIT_L(0); PG8_BAR; PG8_MMA(1, 0, At, B0); PG8_MMA(1, 1, At, B1); PG8_BAR; PG8_SCHED;
            PG8_LDB(B0, 1, 0); PG8_LDB(B1, 1, 1); PG8_SCHED; PG8_LDA(At, 1, 0); PG8_STAGE(PG8_SA(0, 1), a2 + hstep, voffA);
            PG8_WAIT_V(8); PG8_WAIT_L(0); PG8_BAR; PG8_MMA(0, 0, At, B0); PG8_MMA(0, 1, At, B1); PG8_BAR; PG8_SCHED;
            PG8_LDA(At, 1, 1); PG8_STAGE(PG8_SB(1, 0), b3, voffB); PG8_STAGE(PG8_SB(1, 1), b3 + hstep, voffB); PG8_STAGE(PG8_SA(1, 0), a3, voffA);
            PG8_WAIT_V(8); PG8_WAIT_L(0); PG8_BAR; PG8_MMA(1, 0, At, B0); PG8_MMA(1, 1, At, B1); PG8_BAR; PG8_SCHED;
            } else {
            PG8_LDB(B0, 0, 0); PG8_SCHED; PG8_LDA(At, 0, 0); PG8_STAGE(PG8_SA(1, 1), a1 + hstep, voffA);
            PG8_WAIT_L(8); PG8_BAR; PG8_WAIT_L(0); PG8_MMA(0, 0, At, B0); PG8_BAR; PG8_SCHED;
            PG8_LDB(B1, 0, 1); PG8_STAGE(PG8_SB(0, 0), b2, voffB);
            PG8_BAR; PG8_WAIT_L(0); PG8_MMA(0, 1, At, B1); PG8_BAR;
            PG8_LDA(At, 0, 1); PG8_STAGE(PG8_SA(0, 0), a2, voffA);
            PG8_BAR; PG8_WAIT_L(0); PG8_MMA(1, 0, At, B0); PG8_BAR; PG8_SCHED;
            PG8_STAGE(PG8_SB(0, 1), b2 + hstep, voffB);
            PG8_WAIT_V(6); PG8_BAR; PG8_MMA(1, 1, At, B1); PG8_BAR;
            PG8_LDB(B0, 1, 0); PG8_SCHED; PG8_LDA(At, 1, 0); PG8_STAGE(PG8_SA(0, 1), a2 + hstep, voffA);
            PG8_WAIT_L(8); PG8_BAR; PG8_WAIT_L(0); PG8_MMA(0, 0, At, B0); PG8_BAR; PG8_SCHED;
            PG8_LDB(B1, 1, 1); PG8_STAGE(PG8_SB(1, 0), b3, voffB);
            PG8_BAR; PG8_WAIT_L(0); PG8_MMA(0, 1, At, B1); PG8_BAR;
            PG8_LDA(At, 1, 1); PG8_STAGE(PG8_SA(1, 0), a3, voffA);
            PG8_BAR; PG8_WAIT_L(0); PG8_MMA(1, 0, At, B0); PG8_BAR; PG8_SCHED;
            PG8_STAGE(PG8_SB(1, 1), b3 + hstep, voffB);
            PG8_WAIT_V(6); PG8_BAR; PG8_MMA(1, 1, At, B1); PG8_BAR;
            }
        }
        if constexpr (ALIGN_EPI) { if (wr == 0) PG8_BAR; }
        if constexpr (!Epi::AFTER_DRAIN) { E(acc, cur, wr, wc, fr, fq); S.done(cur); }
        if (!has_next) break;
#pragma unroll
        for (int a = 0; a < 2; ++a)
#pragma unroll
            for (int b = 0; b < 2; ++b)
#pragma unroll
                for (int m = 0; m < 4; ++m)
#pragma unroll
                    for (int n = 0; n < 2; ++n) acc[a][b][m][n] = (f32x4){0.f, 0.f, 0.f, 0.f};
        cur = nxt; cA = nA; cB = nB; ++ui;
        if constexpr (ALIGN_EPI) { if (wr == 1) PG8_BAR; }
    }
    PG8_WAIT_V(0);
    if constexpr (!ALIGN_EPI) { if (wr == 0) PG8_BAR; }
    PG8_BAR;
    if constexpr (Epi::AFTER_DRAIN) { E.fused(acc, cur, wr, wc, fr, fq, lds, wid, lane); S.done(cur); }
#undef PG8_SA
#undef PG8_SB
#undef PG8_STAGE
#undef PG8_LDA
#undef PG8_LDB
#undef PG8_MMA
#undef PG8_WAIT_V
#undef PG8_WAIT_L
#undef PG8_BAR
#undef PG8_SCHED
}
}

struct Ctx {
    LAS unsigned char* lds;
    int wave, G, bid, xcd, rank, nloc;
};
__device__ __forceinline__ int fresh_tid() { int t = threadIdx.x; asm volatile("" : "+v"(t)); return t; }
__device__ __forceinline__ int own_nrows(int x) { return 2048 + (x < 2 ? 256 : 0); }
__device__ __forceinline__ int own_row(int x, int l) { return l < 2048 ? x * 2048 + l : MP + x * 256 + (l - 2048); }
#define LDS_WAIT() asm volatile("s_waitcnt lgkmcnt(0)" ::: "memory")
__device__ __forceinline__ bf16x8 ldfrag(const LAS bf16_t* base, int stride, int row, int k0) { return *(const LAS bf16x8*)(base + row * stride + k0); }
#define MFMA16(a, b, c) __builtin_amdgcn_mfma_f32_16x16x32_bf16((a), (b), (c), 0, 0, 0)

__device__ __forceinline__ void p0_transpose_item(const float* W, int N, bf16_t* WT, int ldT, int row_off, int col_off, LAS float* scr, int item, int lane) {
    const int nblk = N / 32, kb = item / nblk, nb = item % nblk, k0 = 64 * kb, n0 = 32 * nb;
#pragma unroll 8
    for (int i = 0; i < 32; ++i) { const int kk = 2 * i + (lane >> 5); scr[kk * 33 + (lane & 31)] = W[(size_t)(k0 + kk) * N + n0 + (lane & 31)]; }
    LDS_WAIT(); asm volatile("" ::: "memory");
    const int c = lane & 7;
#pragma unroll
    for (int j = 0; j < 4; ++j) { const int n = (lane >> 3) + 8 * j; const LAS float* s = scr + (8 * c) * 33 + n;
        u32x4 o; o.x = cvt_pk(s[0 * 33], s[1 * 33]); o.y = cvt_pk(s[2 * 33], s[3 * 33]); o.z = cvt_pk(s[4 * 33], s[5 * 33]); o.w = cvt_pk(s[6 * 33], s[7 * 33]);
        *(u32x4*)(WT + (size_t)(row_off + n0 + n) * ldT + col_off + k0 + 8 * c) = o; }
    LDS_WAIT(); asm volatile("" ::: "memory");
}
__device__ __forceinline__ void cvt_rows(const float* src, bf16_t* dst, size_t n8, size_t gt, size_t GT) {
    for (size_t i = gt; i < n8; i += GT) { const f32x4 a = *(const f32x4*)(src + i * 8), b = *(const f32x4*)(src + i * 8 + 4);
        u32x4 o; o.x = cvt_pk(a[0], a[1]); o.y = cvt_pk(a[2], a[3]); o.z = cvt_pk(b[0], b[1]); o.w = cvt_pk(b[2], b[3]); *(u32x4*)(dst + i * 8) = o; }
}

__device__ __forceinline__ void p0_prep(const Ctx& C, const Args& a) {
    unsigned char* ws = a.ws;
    bf16_t* WinT = (bf16_t*)(ws + WS_WIN); bf16_t* WmemT = (bf16_t*)(ws + WS_WMEM); bf16_t* WbrT = (bf16_t*)(ws + WS_WBR); bf16_t* WoutT = (bf16_t*)(ws + WS_WOUT);
    bf16_t* WguT = (bf16_t*)(ws + WS_WGU); bf16_t* WdownT = (bf16_t*)(ws + WS_WDOWN);
    const int tid = fresh_tid(), lane = tid & 63;
    LAS float* scr = (LAS float*)(C.lds + C.wave * 16384);
    const int gw = C.bid * 8 + C.wave, NGW = C.G * 8;
    constexpr int I_IN = 16 * 176, I_MK = 16 * 8, I_BH = 8 * 32, I_BM = 4 * 32, I_OUT = 16 * 32, I_GT = 16 * 88, I_DN = 44 * 32;
    constexpr int NITEMS = I_IN + 2 * I_MK + I_BH + I_BM + I_OUT + 2 * I_GT + I_DN;
    for (int it = gw; it < NITEMS; it += NGW) {
        int r = it;
        if (r < I_IN) { p0_transpose_item(a.in[I_WIN], INC, WinT, 1024, 0, 0, scr, r, lane); continue; } r -= I_IN;
        if (r < I_MK) { p0_transpose_item(a.in[I_WMK], 256, WmemT, 1024, 0, 0, scr, r, lane); continue; } r -= I_MK;
        if (r < I_MK) { p0_transpose_item(a.in[I_WMV], 256, WmemT, 1024, 256, 0, scr, r, lane); continue; } r -= I_MK;
        if (r < I_BH) { p0_transpose_item(a.in[I_WBH], 1024, WbrT, 1024, 0, 256, scr, r, lane); continue; } r -= I_BH;
        if (r < I_BM) { p0_transpose_item(a.in[I_WBM], 1024, WbrT, 1024, 0, 768, scr, r, lane); continue; } r -= I_BM;
        if (r < I_OUT) { p0_transpose_item(a.in[I_WOUT], 1024, WoutT, 1024, 0, 0, scr, r, lane); continue; } r -= I_OUT;
        if (r < I_GT) { p0_transpose_item(a.in[I_WGATE], DFF, WguT, 1024, 0, 0, scr, r, lane); continue; } r -= I_GT;
        if (r < I_GT) { p0_transpose_item(a.in[I_WUP], DFF, WguT, 1024, DFF, 0, scr, r, lane); continue; } r -= I_GT;
        p0_transpose_item(a.in[I_WDOWN], 1024, WdownT, DFF, 0, 0, scr, r, lane);
    }
    const size_t gt = (size_t)C.bid * 512 + tid, GT = (size_t)C.G * 512;
    for (size_t i = gt; i < 256 * 1024; i += GT) {
        const int k = (int)(i >> 10), n = (int)(i & 1023), g = k >> 6;
        const float* wg = a.in[I_WGRP] + (size_t)k * 64; const float* sc = a.in[I_PSCALE] + g * 64; const float* wb = a.in[I_WBP] + (size_t)(g * 64) * 1024 + n;
        float s = 0.f;
#pragma unroll 8
        for (int d = 0; d < 64; ++d) s += wg[d] * sc[d] * wb[(size_t)d * 1024];
        WbrT[(size_t)n * 1024 + k] = f2bf(s);
    }
    if (gt < 512) { const float* l = a.in[I_LB]; ((float*)(ws + WS_LBT))[gt] = 1.0f / (1.0f + __expf(l[512 + gt] - l[gt])); }
    bf16_t* Xh = (bf16_t*)(ws + WS_XH);
#if defined(NAN_MEMKV)
    for (size_t i = gt; i < 2 * 524288; i += GT) ((unsigned*)(a.out + O_MEMK))[i] = 0x7fc00000u;
#endif
    {
        const int ox = C.xcd, orank = C.rank, onloc = C.nloc, onr = own_nrows(ox);
        for (int i = orank * 512 + tid; i < onr * 128; i += onloc * 512) { const int row = own_row(ox, i >> 7), g8 = (i & 127) * 8;
            const float* src = row < MP ? a.in[I_XP] + (size_t)row * 1024 + g8 : a.in[I_XS] + (size_t)(row - MP) * 1024 + g8;
            const f32x4 v0 = *(const f32x4*)src, v1 = *(const f32x4*)(src + 4);
            u32x4 o; o.x = cvt_pk(v0[0], v0[1]); o.y = cvt_pk(v0[2], v0[3]); o.z = cvt_pk(v1[0], v1[1]); o.w = cvt_pk(v1[2], v1[3]); *(u32x4*)(Xh + (size_t)row * 1024 + g8) = o; }
        for (int i = orank * 512 + tid; i < 256 * 128; i += onloc * 512) { const size_t e = ((size_t)(ox * 256 + (i >> 7))) * 1024 + (i & 127) * 8;
            const f32x4 v0 = *(const f32x4*)(a.in[I_MEMP] + e), v1 = *(const f32x4*)(a.in[I_MEMP] + e + 4);
            u32x4 o; o.x = cvt_pk(v0[0], v0[1]); o.y = cvt_pk(v0[2], v0[3]); o.z = cvt_pk(v1[0], v1[1]); o.w = cvt_pk(v1[2], v1[3]); *(u32x4*)((bf16_t*)(ws + WS_MEMH) + e) = o; }
    }
}

__device__ __forceinline__ void hgrn_prompt_unit(const Ctx& C, const Args& a, int unit) {
    const int b = unit >> 4, h = (unit >> 2) & 3, eq = unit & 3;
    const float* LF = a.out + OY_LF; const bf16_t* Q = (const bf16_t*)(a.out + OY_Q); const bf16_t* KK = (const bf16_t*)(a.out + OY_KK);
    const bf16_t* V = (const bf16_t*)(a.ws + WS_V); float* OB = (float*)(a.ws + WS_OB);
    LAS bf16_t* Qp = (LAS bf16_t*)C.lds;
    LAS bf16_t* Kp = Qp + 64 * 136;
    LAS bf16_t* KT = Kp + 64 * 136;
    LAS bf16_t* VT = KT + 128 * 72;
    LAS bf16_t* SC = VT + 32 * 72;
    LAS bf16_t* ST = SC + 64 * 72;
    LAS float* blast = (LAS float*)(ST + 32 * 136);
    LAS float* part = blast + 128;
    const int tid = fresh_tid(), lane = tid & 63, w = C.wave, l16 = lane & 15, q4 = lane >> 4;
    const int d = tid & 127, tq = tid >> 7;
    for (int i = tid; i < 32 * 136 / 2; i += 512) ((LAS unsigned*)ST)[i] = 0u;
    f32x4 sacc[2]; sacc[0] = (f32x4){0.f, 0.f, 0.f, 0.f}; sacc[1] = sacc[0];
    const int vt = tid >> 3, ve = (tid & 7) * 4;
    float lfr[16]; unsigned short qr[16], kr[16]; u32x2 vr;
#define HG_LOAD(cc) do { const int rb_ = b * SEQ + (cc) * 64; _Pragma("unroll") for (int i = 0; i < 16; ++i) { const size_t idx = (size_t)(rb_ + tq * 16 + i) * 512 + h * 128 + d; \
        lfr[i] = LF[idx]; qr[i] = Q[idx]; kr[i] = KK[idx]; } vr = *(const u32x2*)(V + (size_t)(rb_ + vt) * 512 + h * 128 + eq * 32 + ve); } while (0)
    HG_LOAD(0);
    for (int c = 0; c < SEQ / 64; ++c) {
        const int rbase = b * SEQ + c * 64;
        float bl[16], qv[16], kv[16]; float run = 0.f;
#pragma unroll
        for (int i = 0; i < 16; ++i) { run += lfr[i]; bl[i] = run; qv[i] = bf2f(qr[i]); kv[i] = bf2f(kr[i]); }
        const u32x2 vraw = vr;
        if (c + 1 < SEQ / 64) HG_LOAD(c + 1);
        part[tq * 128 + d] = run;
        __syncthreads();
        float off = 0.f, tot = 0.f;
#pragma unroll
        for (int p = 0; p < 4; ++p) { const float x = part[p * 128 + d]; tot += x; if (p < tq) off += x; }
        if (tq == 0) blast[d] = tot;
        unsigned ktp[8];
#pragma unroll
        for (int i = 0; i < 16; i += 2) {
            const float b0 = bl[i] + off, b1 = bl[i + 1] + off;
            Qp[(tq * 16 + i) * 136 + d] = f2bf(qv[i] * __expf(b0)); Qp[(tq * 16 + i + 1) * 136 + d] = f2bf(qv[i + 1] * __expf(b1));
            Kp[(tq * 16 + i) * 136 + d] = f2bf(kv[i] * __expf(-b0)); Kp[(tq * 16 + i + 1) * 136 + d] = f2bf(kv[i + 1] * __expf(-b1));
            ktp[i >> 1] = cvt_pk(kv[i] * __expf(tot - b0), kv[i + 1] * __expf(tot - b1));
        }
        *(LAS u32x4*)(KT + d * 72 + tq * 16) = (u32x4){ktp[0], ktp[1], ktp[2], ktp[3]};
        *(LAS u32x4*)(KT + d * 72 + tq * 16 + 8) = (u32x4){ktp[4], ktp[5], ktp[6], ktp[7]};
        VT[(ve + 0) * 72 + vt] = (bf16_t)(vraw.x & 0xffffu); VT[(ve + 1) * 72 + vt] = (bf16_t)(vraw.x >> 16);
        VT[(ve + 2) * 72 + vt] = (bf16_t)(vraw.y & 0xffffu); VT[(ve + 3) * 72 + vt] = (bf16_t)(vraw.y >> 16);
        __syncthreads();
#pragma unroll
        for (int bi = 0; bi < 2; ++bi) {
            const int blk = 2 * w + bi, tb = blk >> 2, sb = blk & 3;
            f32x4 acc = (f32x4){0.f, 0.f, 0.f, 0.f};
            if (sb <= tb) {
#pragma unroll
                for (int kk = 0; kk < 4; ++kk) acc = MFMA16(ldfrag(Kp, 136, sb * 16 + l16, kk * 32 + q4 * 8), ldfrag(Qp, 136, tb * 16 + l16, kk * 32 + q4 * 8), acc);
                const int t = tb * 16 + l16, s0 = sb * 16 + 4 * q4;
#pragma unroll
                for (int j = 0; j < 4; ++j) if (s0 + j > t) acc[j] = 0.f;
            }
            *(LAS u32x2*)(SC + (tb * 16 + l16) * 72 + sb * 16 + 4 * q4) = pk4(acc);
        }
        __syncthreads();
        {
            const int tb = w >> 1, eb = w & 1;
            f32x4 acc = (f32x4){0.f, 0.f, 0.f, 0.f};
#pragma unroll
            for (int kk = 0; kk < 2; ++kk) acc = MFMA16(ldfrag(VT, 72, eb * 16 + l16, kk * 32 + q4 * 8), ldfrag(SC, 72, tb * 16 + l16, kk * 32 + q4 * 8), acc);
#pragma unroll
            for (int kk = 0; kk < 4; ++kk) acc = MFMA16(ldfrag(ST, 136, eb * 16 + l16, kk * 32 + q4 * 8), ldfrag(Qp, 136, tb * 16 + l16, kk * 32 + q4 * 8), acc);
            *(f32x4*)(OB + (size_t)(rbase + tb * 16 + l16) * 512 + h * 128 + eq * 32 + eb * 16 + 4 * q4) = acc;
        }
        {
            const f32x4 bl4 = *(const LAS f32x4*)(blast + 16 * w + 4 * q4);
            f32x4 dec; _Pragma("unroll") for (int j = 0; j < 4; ++j) dec[j] = __expf(bl4[j]);
#pragma unroll
            for (int nb = 0; nb < 2; ++nb) {
                sacc[nb] = sacc[nb] * dec;
#pragma unroll
                for (int kk = 0; kk < 2; ++kk) sacc[nb] = MFMA16(ldfrag(KT, 72, 16 * w + l16, kk * 32 + q4 * 8), ldfrag(VT, 72, nb * 16 + l16, kk * 32 + q4 * 8), sacc[nb]);
            }
        }
        __syncthreads();
#pragma unroll
        for (int nb = 0; nb < 2; ++nb) *(LAS u32x2*)(ST + (nb * 16 + l16) * 136 + 16 * w + 4 * q4) = pk4(sacc[nb]);
    }
    float* SO = a.out + O_HGP + (size_t)(b * 4 + h) * 16384;
#pragma unroll
    for (int nb = 0; nb < 2; ++nb)
#pragma unroll
        for (int j = 0; j < 4; ++j) SO[(size_t)(16 * w + 4 * q4 + j) * 128 + eq * 32 + nb * 16 + l16] = sacc[nb][j];
    __syncthreads();
}

__device__ __forceinline__ void hgrn_sample_unit(const Ctx& C, const Args& a, int unit) {
    const int b = unit >> 2, h = unit & 3;
    const float* LF = a.out + OY_LF; const bf16_t* Q = (const bf16_t*)(a.out + OY_Q); const bf16_t* KK = (const bf16_t*)(a.out + OY_KK);
    const bf16_t* V = (const bf16_t*)(a.ws + WS_V); float* OB = (float*)(a.ws + WS_OB);
    LAS float* qs = (LAS float*)C.lds; LAS float* ks = qs + 512; LAS float* fs = ks + 512; LAS float* vs = fs + 512; LAS float* red = vs + 512;
    const int tid = fresh_tid();
    { const int j = tid >> 7, d = tid & 127; const size_t idx = (size_t)(MP + b * 4 + j) * 512 + h * 128 + d;
      qs[tid] = bf2f(Q[idx]); ks[tid] = bf2f(KK[idx]); fs[tid] = __expf(LF[idx]); vs[tid] = bf2f(V[idx]); }
    const int e = (tid & 31) * 4, dg = tid >> 5, d0 = dg * 8;
    const float* S0 = a.in[I_SHG] + (size_t)(b * 4 + h) * 16384;
    f32x4 S[8];
#pragma unroll
    for (int i = 0; i < 8; ++i) S[i] = *(const f32x4*)(S0 + (size_t)(d0 + i) * 128 + e);
    __syncthreads();
#pragma unroll
    for (int j = 0; j < 4; ++j) {
        const f32x4 v4 = *(const LAS f32x4*)(vs + j * 128 + e); f32x4 po = (f32x4){0.f, 0.f, 0.f, 0.f};
#pragma unroll
        for (int i = 0; i < 8; ++i) { const float f = fs[j * 128 + d0 + i], k = ks[j * 128 + d0 + i], q = qs[j * 128 + d0 + i]; S[i] = S[i] * f + v4 * k; po += S[i] * q; }
        *(LAS f32x4*)(red + (j * 16 + dg) * 128 + e) = po;
    }
    __syncthreads();
    { const int j = tid >> 7, ee = tid & 127; float s = 0.f;
#pragma unroll
      for (int g = 0; g < 16; ++g) s += red[(j * 16 + g) * 128 + ee];
      OB[(size_t)(MP + b * 4 + j) * 512 + h * 128 + ee] = s; }
    float* SO = a.out + O_HGS + (size_t)(b * 4 + h) * 16384;
#pragma unroll
    for (int i = 0; i < 8; ++i) *(f32x4*)(SO + (size_t)(d0 + i) * 128 + e) = S[i];
    __syncthreads();
}

template <int PARTS> __device__ __forceinline__ void attn_rows(const LAS float* Kf, const LAS float* Vf, const bf16_t* QC, bf16_t* YC, int r0, int Lq, int h, int tl) {
    const int qi = tl / PARTS, part = tl % PARTS; const int qrow = r0 + (qi < Lq ? qi : Lq - 1);
    f32x4 q[16], o[16];
#pragma unroll
    for (int j = 0; j < 8; ++j) { const u32x4 w = *(const u32x4*)(QC + (size_t)qrow * 256 + h * 64 + j * 8);
        q[2 * j] = (f32x4){bflo(w.x), bfhi(w.x), bflo(w.y), bfhi(w.y)}; q[2 * j + 1] = (f32x4){bflo(w.z), bfhi(w.z), bflo(w.w), bfhi(w.w)}; }
#pragma unroll
    for (int j = 0; j < 16; ++j) o[j] = (f32x4){0.f, 0.f, 0.f, 0.f};
    float m = -3.0e38f, l = 0.f;
#pragma unroll 1
    for (int kk = 0; kk < 256 / PARTS; ++kk) {
        const LAS float* kp = Kf + (kk * PARTS + part) * 68; const LAS float* vp = Vf + (kk * PARTS + part) * 68;
        f32x4 acc = (f32x4){0.f, 0.f, 0.f, 0.f};
#pragma unroll
        for (int j = 0; j < 16; ++j) acc += q[j] * *(const LAS f32x4*)(kp + 4 * j);
        const float s = (acc[0] + acc[1]) + (acc[2] + acc[3]);
        const float mn = fmaxf(m, s), sc = __expf(m - mn), p = __expf(s - mn);
        l = l * sc + p; m = mn;
#pragma unroll
        for (int j = 0; j < 16; ++j) o[j] = o[j] * sc + *(const LAS f32x4*)(vp + 4 * j) * p;
    }
#pragma unroll
    for (int off = 1; off < PARTS; off <<= 1) {
        const float m2 = __shfl_xor(m, off), l2 = __shfl_xor(l, off); const float mn = fmaxf(m, m2), a1 = __expf(m - mn), a2 = __expf(m2 - mn);
        l = l * a1 + l2 * a2; m = mn;
#pragma unroll
        for (int j = 0; j < 16; ++j) { f32x4 o2; o2[0] = __shfl_xor(o[j][0], off); o2[1] = __shfl_xor(o[j][1], off); o2[2] = __shfl_xor(o[j][2], off); o2[3] = __shfl_xor(o[j][3], off); o[j] = o[j] * a1 + o2 * a2; }
    }
    if (part == 0 && qi < Lq) { const float inv = 1.0f / l; bf16_t* dst = YC + (size_t)(r0 + qi) * 1024 + 768 + h * 64;
#pragma unroll
        for (int j = 0; j < 16; ++j) *(u32x2*)(dst + 4 * j) = pk4(o[j] * inv); }
}
__device__ __forceinline__ void attn_unit_mfma(const Ctx& C, const Args& a, int unit) {
    int b, h, r0, Lq; const float *Ks, *Vs;
    if (unit < 512) { b = unit >> 6; h = (unit >> 4) & 3; r0 = b * SEQ + (unit & 15) * 128; Lq = 128; Ks = a.out + O_MEMK + (size_t)b * 65536; Vs = a.out + O_MEMV + (size_t)b * 65536; }
    else { const int u2 = unit - 512; b = u2 >> 2; h = u2 & 3; r0 = MP + b * 4; Lq = 4; Ks = a.in[I_CK] + (size_t)b * 65536; Vs = a.in[I_CV] + (size_t)b * 65536; }
    const bf16_t* QC = (const bf16_t*)(a.ws + WS_QC); bf16_t* YC = (bf16_t*)(a.ws + WS_XH);
    LAS bf16_t* Kl = (LAS bf16_t*)C.lds;
    LAS bf16_t* VT = Kl + 256 * 72;
    LAS bf16_t* Pl = VT + 64 * 264 + C.wave * (16 * 264);
    const int tid = fresh_tid(), lane = tid & 63, w = C.wave, l16 = lane & 15, q4 = lane >> 4;
#pragma unroll
    for (int i = 0; i < 8; ++i) { const int idx = tid + i * 512, key = idx >> 4, d4 = (idx & 15) * 4;
        const f32x4 kf = *(const f32x4*)(Ks + (size_t)key * 256 + h * 64 + d4), vf = *(const f32x4*)(Vs + (size_t)key * 256 + h * 64 + d4);
        *(LAS u32x2*)(Kl + key * 72 + d4) = pk4(kf);
        const u32x2 vp = pk4(vf);
        VT[(d4 + 0) * 264 + key] = (bf16_t)(vp.x & 0xffffu); VT[(d4 + 1) * 264 + key] = (bf16_t)(vp.x >> 16);
        VT[(d4 + 2) * 264 + key] = (bf16_t)(vp.y & 0xffffu); VT[(d4 + 3) * 264 + key] = (bf16_t)(vp.y >> 16); }
    __syncthreads();
    {
        const int qi = w * 16 + l16, qrow = r0 + (qi < Lq ? qi : Lq - 1);
        bf16x8 qf[2];
#pragma unroll
        for (int kk = 0; kk < 2; ++kk) qf[kk] = *(const bf16x8*)(QC + (size_t)qrow * 256 + h * 64 + kk * 32 + q4 * 8);
        f32x4 s[16]; float mx = -3.0e38f;
#pragma unroll
        for (int mb = 0; mb < 16; ++mb) { f32x4 acc = (f32x4){0.f, 0.f, 0.f, 0.f};
#pragma unroll
            for (int kk = 0; kk < 2; ++kk) acc = MFMA16(ldfrag(Kl, 72, mb * 16 + l16, kk * 32 + q4 * 8), qf[kk], acc);
            s[mb] = acc; mx = fmaxf(mx, fmaxf(fmaxf(acc[0], acc[1]), fmaxf(acc[2], acc[3]))); }
        mx = fmaxf(mx, __shfl_xor(mx, 16)); mx = fmaxf(mx, __shfl_xor(mx, 32));
        float sum = 0.f;
#pragma unroll
        for (int mb = 0; mb < 16; ++mb) { f32x4 p; _Pragma("unroll") for (int j = 0; j < 4; ++j) { p[j] = __expf(s[mb][j] - mx); sum += p[j]; }
            *(LAS u32x2*)(Pl + l16 * 264 + mb * 16 + 4 * q4) = pk4(p); }
        sum += __shfl_xor(sum, 16); sum += __shfl_xor(sum, 32);
        const float inv = 1.0f / sum;
        __syncthreads();
#pragma unroll
        for (int db = 0; db < 4; ++db) { f32x4 acc = (f32x4){0.f, 0.f, 0.f, 0.f};
#pragma unroll
            for (int kb = 0; kb < 8; ++kb) acc = MFMA16(ldfrag(VT, 264, db * 16 + l16, kb * 32 + q4 * 8), ldfrag(Pl, 264, l16, kb * 32 + q4 * 8), acc);
            if (qi < Lq) *(u32x2*)(YC + (size_t)(r0 + qi) * 1024 + 768 + h * 64 + db * 16 + 4 * q4) = pk4(acc * inv); }
    }
    __syncthreads();
}

__device__ __forceinline__ void attn_unit(const Ctx& C, const Args& a, int unit) {
    int b, h, r0; const float *Ks, *Vs;
    if (unit < 512) { b = unit >> 6; h = (unit >> 4) & 3; r0 = b * SEQ + (unit & 15) * 128; Ks = a.out + O_MEMK + (size_t)b * 65536; Vs = a.out + O_MEMV + (size_t)b * 65536; }
    else { const int u2 = unit - 512; b = u2 >> 2; h = u2 & 3; r0 = MP + b * 4; Ks = a.in[I_CK] + (size_t)b * 65536; Vs = a.in[I_CV] + (size_t)b * 65536; }
    const bf16_t* QC = (const bf16_t*)(a.ws + WS_QC); bf16_t* YC = (bf16_t*)(a.ws + WS_XH);
    LAS float* Kf = (LAS float*)C.lds;
    LAS float* Vf = Kf + 256 * 68;
    const int tid = fresh_tid();
#pragma unroll
    for (int i = 0; i < 8; ++i) { const int idx = tid + i * 512, key = idx >> 4, d4 = (idx & 15) * 4;
        *(LAS f32x4*)(Kf + key * 68 + d4) = *(const f32x4*)(Ks + (size_t)key * 256 + h * 64 + d4);
        *(LAS f32x4*)(Vf + key * 68 + d4) = *(const f32x4*)(Vs + (size_t)key * 256 + h * 64 + d4); }
    __syncthreads();
    if (unit < 512) attn_rows<4>(Kf, Vf, QC, YC, r0, 128, h, tid);
    else if (C.wave == 0) attn_rows<16>(Kf, Vf, QC, YC, r0, 4, h, tid);
    __syncthreads();
}

template <int WN> __device__ __forceinline__ void pool_rows_prompt(const float* UA, bf16_t* YC, float* outp, int R0, int c) {
    const int t0 = R0 & (SEQ - 1);
    float v[47];
#pragma unroll
    for (int i = 0; i < 15; ++i) v[i] = t0 > 0 ? UA[(size_t)(R0 - 15 + i) * 256 + c] : 0.f;
#pragma unroll
    for (int i = 0; i < 32; ++i) v[15 + i] = UA[(size_t)(R0 + i) * 256 + c];
    float S = 0.f;
#pragma unroll
    for (int k = 1; k < WN; ++k) S += v[15 - k];
#pragma unroll
    for (int i = 0; i < 32; ++i) {
        S += v[15 + i];
        const int t = t0 + i; const float cnt = (float)(t + 1 < WN ? t + 1 : WN);
        YC[(size_t)(R0 + i) * 1024 + c] = f2bf(S / cnt - v[15 + i]);
        if (t >= SEQ - 15) outp[((size_t)((R0 + i) >> 11) * 15 + (t - (SEQ - 15))) * 256 + c] = v[15 + i];
        S -= v[15 + i - (WN - 1)];
    }
}
__device__ __forceinline__ void pool_unit(const Ctx& C, const Args& a, int unit) {
    const float* UA = (const float*)(a.ws + WS_UA); bf16_t* YC = (bf16_t*)(a.ws + WS_XH);
    const int tid = fresh_tid(); const int c = tid & 255, half = tid >> 8, g = c >> 6, wn = 2 << g;
    if (unit < MP / 64) {
        const int R0 = unit * 64 + half * 32; float* outp = a.out + O_POOLP;
        if (g == 0) pool_rows_prompt<2>(UA, YC, outp, R0, c); else if (g == 1) pool_rows_prompt<4>(UA, YC, outp, R0, c);
        else if (g == 2) pool_rows_prompt<8>(UA, YC, outp, R0, c); else pool_rows_prompt<16>(UA, YC, outp, R0, c);
        return;
    }
    for (int i = 0; i < 32; ++i) {
        const int row = unit * 64 + half * 32 + i;
        const float u = UA[(size_t)row * 256 + c]; float s = u;
        const int j = row & 3, bb = (row - MP) >> 2; const float cnt = (float)wn;
        const float* sp = a.in[I_SPOOL] + (size_t)bb * 15 * 256 + c;
        for (int k = 1; k < wn; ++k) { const int p = j - k; s += p >= 0 ? UA[(size_t)(row - k) * 256 + c] : sp[(size_t)(15 + p) * 256]; }
        float* po = a.out + O_POOLS + (size_t)bb * 15 * 256 + c;
        po[(size_t)(11 + j) * 256] = u;
        if (j == 0) for (int k = 0; k < 11; ++k) po[(size_t)k * 256] = sp[(size_t)(k + 4) * 256];
        YC[(size_t)row * 1024 + c] = f2bf(s / cnt - u);
    }
}

__device__ __forceinline__ int fetch_unit(const Ctx& C, unsigned* ctr, volatile LAS int* slot) {
    __syncthreads();
    if (fresh_tid() == 0) *slot = (int)atomicAdd(ctr, 1u);
    __syncthreads();
    return *slot;
}

__device__ __forceinline__ void ln_row(const float* src, bf16_t* oh, float* of, const float* g, const float* bta, int lane, const float* part = nullptr, int nparts = 0, const float* rx = nullptr, const bf16_t* rh = nullptr) {
    f32x4 v[4]; float s = 0.f;
#pragma unroll
    for (int j = 0; j < 4; ++j) {
        if (part) { v[j] = rx ? *(const f32x4*)(rx + 4 * lane + 256 * j) * DN_ALPHA : unpk4(*(const u32x2*)(rh + 4 * lane + 256 * j)) * DN_ALPHA;
            for (int p = 0; p < nparts; ++p) v[j] += *(const f32x4*)(part + (size_t)p * (512 * 1024) + 4 * lane + 256 * j); }
        else v[j] = *(const f32x4*)(src + 4 * lane + 256 * j);
        s += (v[j][0] + v[j][1]) + (v[j][2] + v[j][3]); }
    const float mean = wave_sum(s) * (1.f / 1024.f); float s2 = 0.f;
#pragma unroll
    for (int j = 0; j < 4; ++j) { v[j] = v[j] - mean; s2 += (v[j][0] * v[j][0] + v[j][1] * v[j][1]) + (v[j][2] * v[j][2] + v[j][3] * v[j][3]); }
    const float rstd = 1.f / sqrtf(wave_sum(s2) * (1.f / 1024.f) + LN_EPS);
#pragma unroll
    for (int j = 0; j < 4; ++j) { const f32x4 gg = *(const f32x4*)(g + 4 * lane + 256 * j), bb = *(const f32x4*)(bta + 4 * lane + 256 * j); const f32x4 o = v[j] * rstd * gg + bb;
        if (oh) *(u32x2*)(oh + 4 * lane + 256 * j) = pk4(o); else *(f32x4*)(of + 4 * lane + 256 * j) = o; }
}

#define XB_TMO      128
#define XB_XCNT(j)  (256  + 64 * (j))
#define XB_XSUB(j)  (1280 + 64 * (j))
#define XB_XGEN(j)  (2304 + 64 * (j))
#define XB_TOP      3328
#define XB_TOPGEN   3392
#define XCD_BAR_WORDS 3456
#define XB_SPIN_CAP (1u << 18)

__device__ __forceinline__ unsigned xb_ld(unsigned* p)              { return __hip_atomic_load(p, __ATOMIC_RELAXED, __HIP_MEMORY_SCOPE_AGENT); }
__device__ __forceinline__ unsigned xb_add(unsigned* p, unsigned v) { return __hip_atomic_fetch_add(p, v, __ATOMIC_RELAXED, __HIP_MEMORY_SCOPE_AGENT); }
__device__ __forceinline__ unsigned xb_xcc_id() { return (unsigned)__builtin_amdgcn_s_getreg((3 << 11) | 20) & 0xFu; }
#define XB_SPIN(cond, bar) do { unsigned _sp = 0; while (cond) { __builtin_amdgcn_s_sleep(1); \
    if ((++_sp & 255u) == 0u) { if (xb_ld(&(bar)[XB_TMO])) break; if (_sp > XB_SPIN_CAP) { atomicAdd(&(bar)[XB_TMO], 1u); break; } } } } while (0)

struct XcdBarrier {
    unsigned* bar; unsigned x;
    volatile LAS unsigned* st;
};

__device__ __forceinline__ XcdBarrier xcd_barrier_post(unsigned* bar, volatile LAS unsigned* st) {
    XcdBarrier b; b.bar = bar; b.x = xb_xcc_id(); b.st = st;
    if (threadIdx.x == 0) (void)xb_add(&bar[XB_XCNT(b.x)], 1u);
    return b;
}
__device__ __forceinline__ void xcd_barrier_complete(unsigned* bar, unsigned x, unsigned& nloc, unsigned& nx) {
    const unsigned G = gridDim.x * gridDim.y * gridDim.z;
    unsigned sum, cnt, mine, sp = 0u;
    for (;;) {
        sum = 0u; cnt = 0u; mine = 0u;
#pragma unroll
        for (unsigned j = 0; j < 16; ++j) { const unsigned c = xb_ld(&bar[XB_XCNT(j)]); sum += c; cnt += (c > 0u) ? 1u : 0u; mine = (j == x) ? c : mine; }
        if (sum == G) break;
        __builtin_amdgcn_s_sleep(1);
        if ((++sp & 255u) == 0u) { if (xb_ld(&bar[XB_TMO])) break; if (sp > XB_SPIN_CAP) { atomicAdd(&bar[XB_TMO], 1u); break; } }
    }
    nloc = mine > 0u ? mine : 1u; nx = cnt > 0u ? cnt : 1u;
}

__device__ __forceinline__ void xcd_barrier(const XcdBarrier& b) {
    asm volatile("s_waitcnt vmcnt(0)" ::: "memory");
    __syncthreads();
    if (threadIdx.x == 0) {
        unsigned* bar = b.bar;
        __builtin_amdgcn_s_waitcnt(0);
        unsigned nloc = b.st[0], nx = b.st[1];
        if (nloc == 0u) { xcd_barrier_complete(bar, b.x, nloc, nx); b.st[0] = nloc; b.st[1] = nx; }
        const unsigned old = xb_add(&bar[XB_XSUB(b.x)], 1u);
        const unsigned gen = old / nloc;
        if (old + 1u == (gen + 1u) * nloc) {
            __builtin_amdgcn_fence(__ATOMIC_RELEASE, "agent");
            asm volatile("s_waitcnt vmcnt(0)" ::: "memory");
            const unsigned og = xb_add(&bar[XB_TOP], 1u);
            const unsigned tg = og / nx;
            if (og + 1u == (tg + 1u) * nx) xb_add(&bar[XB_TOPGEN], 1u);
            else XB_SPIN(xb_ld(&bar[XB_TOPGEN]) == tg, bar);
            __builtin_amdgcn_fence(__ATOMIC_ACQUIRE, "agent");
            xb_add(&bar[XB_XGEN(b.x)], 1u);
            asm volatile("s_waitcnt vmcnt(0)" ::: "memory");
        } else {
            XB_SPIN(xb_ld(&bar[XB_XGEN(b.x)]) == gen, bar);
            __builtin_amdgcn_fence(__ATOMIC_ACQUIRE, "agent");
            asm volatile("s_waitcnt vmcnt(0)" ::: "memory");
        }
    }
    __syncthreads();
}

__device__ __forceinline__ constexpr int in_size_of(int k) {
    return k == 0 ? 16777216 : k == 1 ? 524288 : k == 2 ? 491520 : k == 3 ? 8388608 : k == 4 ? 720896 : k == 5 ? 8388608 : k == 6 ? 8388608 : k == 7 ? 2097152 : k == 8 ? 1024 : k == 9 ? 5767168 :
           k == 10 ? 16384 : k == 11 ? 256 : k == 12 ? 512 : k == 13 ? 262144 : k == 14 ? 262144 : k == 15 ? 262144 : k == 16 ? 524288 : k == 17 ? 262144 : k == 18 ? 1048576 : k == 19 ? 1024 : k == 20 ? 1024 :
           k == 21 ? 2883584 : k == 22 ? 2883584 : k == 23 ? 8448 : k == 24 ? 2816 : k == 25 ? 2883584 : 1024;
}
__device__ __forceinline__ float gelu_as(float v) {
    const float av = fabsf(v), t = __builtin_amdgcn_rcpf(av * 0.2316418882f + 1.0f);
    float q = t * 0.5307027145f + (-0.7265760135f); q = q * t + 0.7107068705f; q = q * t + (-0.142248368f); q = q * t + 0.127414796f; q = q * t;
    const float e = __builtin_amdgcn_exp2f((v * v) * (-0.72134752044f));
    const float mm = v * (q * e);
    return v < 0.f ? mm : v - mm;
}
__global__ void __launch_bounds__(512, 2) fwd_kernel(Args a) {
    extern __shared__ __attribute__((aligned(16))) unsigned char lds_raw[];
    cg::grid_group grid = cg::this_grid();
    Ctx C; C.lds = (LAS unsigned char*)lds_raw; C.wave = __builtin_amdgcn_readfirstlane((int)threadIdx.x >> 6); C.G = gridDim.x; C.bid = blockIdx.x;
    unsigned char* ws = a.ws;
    unsigned* ctl = (unsigned*)(ws + WS_CTL);
    const int gw = C.bid * 8 + C.wave, NGW = C.G * 8;
    const size_t GT = (size_t)C.G * 512;
    float* YR = a.out + O_Y;
    volatile LAS unsigned* bst = (volatile LAS unsigned*)(C.lds + LDS_BYTES - 32);
    if (threadIdx.x < 2) bst[threadIdx.x] = 0u;
    __syncthreads();
    XcdBarrier bar = xcd_barrier_post(ctl + 1024, bst);
    {
        const unsigned xcc = xb_xcc_id() & 7u; volatile LAS int* rk = (volatile LAS int*)(C.lds + LDS_BYTES - 16);
        if (threadIdx.x == 0) rk[0] = (int)atomicAdd(ctl + 600 + xcc, 1u);
        __syncthreads(); C.xcd = (int)xcc; C.rank = __builtin_amdgcn_readfirstlane(rk[0]);
    }
    grid.sync();
#define GRID_BAR() xcd_barrier(bar)
    C.nloc = __builtin_amdgcn_readfirstlane((int)__hip_atomic_load(ctl + 600 + C.xcd, __ATOMIC_RELAXED, __HIP_MEMORY_SCOPE_AGENT));

    for (int rr_ = 0; rr_ <= ((a.pad >> 0) & 1); ++rr_) {
    p0_prep(C, a);
    GRID_BAR();
    }
    if (a.stop == 0) return;

    for (int rr_ = 0; rr_ <= ((a.pad >> 1) & 1); ++rr_) {
    {
        pg8::Gemm g{(const bf16_t*)(ws + WS_XH), (const bf16_t*)(ws + WS_WIN), MT, INC, 1024, 1024}; pg8::StaticOrder S; S.init(MT, INC, C.G, C.bid);
        pg8::EpiIn E{(float*)(ws + WS_UA), (bf16_t*)(a.out + OY_Q), a.out + OY_LF, (bf16_t*)(a.out + OY_KK), (bf16_t*)(ws + WS_V), (bf16_t*)(ws + WS_G), (bf16_t*)(ws + WS_QC), (bf16_t*)(ws + WS_GATE), (const float*)(ws + WS_LBT)};
        pg8::gemm_phase<pg8::EpiIn, pg8::StaticOrder, true, true>(C.lds, g, S, E);
        pg8::Gemm g2{(const bf16_t*)(ws + WS_MEMH), (const bf16_t*)(ws + WS_WMEM), 2048, 512, 1024, 1024}; pg8::XcdOrder S2; S2.init(2048, 512, C.G, C.bid); S2.own(C.xcd, C.rank, C.nloc); S2.r = (S2.r + 2) % S2.nloc;
        pg8::EpiMem E2{a.out + O_MEMK, a.out + O_MEMV};
        pg8::gemm_phase<pg8::EpiMem, pg8::XcdOrder, true, true>(C.lds, g2, S2, E2);
    }
    GRID_BAR();
    }
    if (a.stop == 1) {
        const float* UA = (const float*)(ws + WS_UA); const float* LF = a.out + OY_LF; const bf16_t* Q = (const bf16_t*)(a.out + OY_Q); const bf16_t* KK = (const bf16_t*)(a.out + OY_KK);
        const bf16_t* V = (const bf16_t*)(ws + WS_V); const bf16_t* G = (const bf16_t*)(ws + WS_G); const bf16_t* QC = (const bf16_t*)(ws + WS_QC); const bf16_t* GT_ = (const bf16_t*)(ws + WS_GATE);
        float* D = a.out + O_HGS; const size_t gt = (size_t)C.bid * 512 + fresh_tid();
        for (size_t i = gt; i < (size_t)MT * 256; i += GT) { const size_t r = i >> 8; const int c = (int)(i & 255);
            float s = UA[r * 256 + c] + bf2f(QC[r * 256 + c]);
            for (int k = c; k < 512; k += 256) s += LF[r * 512 + k] + bf2f(Q[r * 512 + k]) + bf2f(KK[r * 512 + k]) + bf2f(V[r * 512 + k]) + bf2f(G[r * 512 + k]);
            for (int k = c; k < 3072; k += 256) s += bf2f(GT_[r * 3072 + k]);
            D[i] = s; }
        return;
    }

    for (int rr_ = 0; rr_ <= ((a.pad >> 2) & 1); ++rr_) {
    {
        const int ox = C.xcd, orank = C.rank;
        if (orank < 16) { for (int r2_ = 0; r2_ <= ((a.pad >> 9) & 1); ++r2_) hgrn_prompt_unit(C, a, ox * 16 + orank); }
        volatile LAS int* slot = (volatile LAS int*)(C.lds + LDS_BYTES - 64);
        for (;;) {
            const int u = fetch_unit(C, ctl + 64 + 64 * rr_, slot);
            if (u >= 512 + 512 + 512 + 264) break;
            if (u < 512) attn_unit(C, a, 512 + u);
            else if (u < 1024) hgrn_sample_unit(C, a, u - 512);
            else if (u < 1536) attn_unit_mfma(C, a, u - 1024);
            else pool_unit(C, a, u - 1536);
        }
    }
    GRID_BAR();
    }
    if (a.stop == 2) {
        const float* OB = (const float*)(ws + WS_OB); const bf16_t* YC = (const bf16_t*)(ws + WS_XH); const size_t gt = (size_t)C.bid * 512 + fresh_tid();
        for (size_t i = gt; i < (size_t)MT * 1024; i += GT) { const size_t r = i >> 10; const int c = (int)(i & 1023);
            YR[i] = c < 512 ? OB[r * 512 + c] : (c < 768 ? bf2f(YC[r * 1024 + c - 512]) : bf2f(YC[r * 1024 + c])); }
        return;
    }

    {
        const float* OB = (const float*)(ws + WS_OB); const bf16_t* G = (const bf16_t*)(ws + WS_G); bf16_t* YC = (bf16_t*)(ws + WS_XH); const float* gn = a.in[I_HGG];
        const int lane = fresh_tid() & 63; const int ox = C.xcd, orank = C.rank, onloc = C.nloc, onr = own_nrows(ox);
        for (int it = orank * 8 + C.wave; it < onr * 4; it += onloc * 8) {
            const int row = own_row(ox, it >> 2), h = it & 3; const size_t idx = (size_t)row * 512 + h * 128 + 2 * lane;
            const f32x2 o = *(const f32x2*)(OB + idx); const float ss = wave_sum(o[0] * o[0] + o[1] * o[1]);
            const float r = 1.0f / sqrtf(ss * (1.f / 128.f) + RMS_EPS);
            const unsigned gr = *(const unsigned*)(G + idx); const f32x2 gg = *(const f32x2*)(gn + h * 128 + 2 * lane);
            *(unsigned*)(YC + (size_t)row * 1024 + 256 + h * 128 + 2 * lane) = cvt_pk(o[0] * r * gg[0] * bflo(gr), o[1] * r * gg[1] * bfhi(gr));
        }
    }
    GRID_BAR();
    if (a.stop == 3) {
        const bf16_t* YC = (const bf16_t*)(ws + WS_XH); const size_t gt = (size_t)C.bid * 512 + fresh_tid();
        for (size_t i = gt; i < (size_t)MT * 1024; i += GT) YR[i] = bf2f(YC[i]);
        return;
    }

    for (int rr_ = 0; rr_ <= ((a.pad >> 3) & 1); ++rr_) {
    {
        const bf16_t* YC = (const bf16_t*)(ws + WS_XH); const bf16_t* WB = (const bf16_t*)(ws + WS_WBR); const bf16_t* GATE = (const bf16_t*)(ws + WS_GATE);
        float* MF = YR; bf16_t* MH = (bf16_t*)(ws + WS_OB);
        pg8::XcdOrder S; S.init(MT, 1024, C.G, C.bid); S.own(C.xcd, C.rank, C.nloc);
        { pg8::Gemm g{YC, WB, MT, 1024, 256, 1024}; pg8::EpiBr<0> E{GATE, MF, MH}; pg8::gemm_phase<pg8::EpiBr<0>, pg8::XcdOrder, true, true>(C.lds, g, S, E); }
        { pg8::Gemm g{YC + 256, WB + 256, MT, 1024, 512, 1024}; pg8::EpiBr<1> E{GATE, MF, MH}; pg8::gemm_phase<pg8::EpiBr<1>, pg8::XcdOrder, true, true>(C.lds, g, S, E); }
        { pg8::Gemm g{YC + 768, WB + 768, MT, 1024, 256, 1024}; pg8::EpiBr<2> E{GATE, MF, MH}; pg8::gemm_phase<pg8::EpiBr<2>, pg8::XcdOrder, true, true>(C.lds, g, S, E); }
    }
    GRID_BAR();
    }
    if (a.stop == 4) return;

    for (int rr_ = 0; rr_ <= ((a.pad >> 4) & 1); ++rr_) {
    {
        pg8::Gemm g{(const bf16_t*)(ws + WS_OB), (const bf16_t*)(ws + WS_WOUT), MT, 1024, 1024, 1024}; pg8::SplitOrder S; S.init(1024, C.G, C.bid, 4);
        pg8::EpiOut E{a.in[I_XP], a.in[I_XS], YR, (float*)(ws + WS_GATE)};
        pg8::gemm_phase<pg8::EpiOut, pg8::SplitOrder, true, true>(C.lds, g, S, E);
    }
    GRID_BAR();
    }
    if (a.stop == 5) return;

    { const int lane = fresh_tid() & 63; const int ox = C.xcd, orank = C.rank, onloc = C.nloc, onr = own_nrows(ox);
      for (int l = orank * 8 + C.wave; l < onr; l += onloc * 8) { const int row = own_row(ox, l);
          if (row < MP) ln_row(YR + (size_t)row * 1024, (bf16_t*)(ws + WS_XH) + (size_t)row * 1024, nullptr, a.in[I_LN1G], a.in[I_LN1B], lane);
          else ln_row(nullptr, (bf16_t*)(ws + WS_XH) + (size_t)row * 1024, nullptr, a.in[I_LN1G], a.in[I_LN1B], lane, (const float*)(ws + WS_GATE) + (size_t)(row - MP) * 1024, 4, a.in[I_XS] + (size_t)(row - MP) * 1024, nullptr); } }
    GRID_BAR();
    if (a.stop == 6) {
        const bf16_t* YC = (const bf16_t*)(ws + WS_XH); const size_t gt = (size_t)C.bid * 512 + fresh_tid();
        for (size_t i = gt; i < (size_t)MT * 1024; i += GT) YR[i] = bf2f(YC[i]);
        return;
    }

    for (int rr_ = 0; rr_ <= ((a.pad >> 6) & 1); ++rr_) {
    {
        pg8::Gemm g{(const bf16_t*)(ws + WS_XH), (const bf16_t*)(ws + WS_WGU), MT, 2 * DFF, 1024, 1024}; pg8::StaticOrder S; S.init(MT, 2 * DFF, C.G, C.bid);
        pg8::EpiFfn1 E{(bf16_t*)(ws + WS_A16), (bf16_t*)(ws + WS_U16), a.out + O_CONVP, a.out + O_CONVS};
        pg8::gemm_phase<pg8::EpiFfn1, pg8::StaticOrder, true, true>(C.lds, g, S, E);
    }
    GRID_BAR();
    }
    if (a.stop == 7) {
        const bf16_t* A_ = (const bf16_t*)(ws + WS_A16); const bf16_t* U_ = (const bf16_t*)(ws + WS_U16); const size_t gt = (size_t)C.bid * 512 + fresh_tid();
        for (size_t i = gt; i < (size_t)MT * 1024; i += GT) { const size_t r = i >> 10; const int c = (int)(i & 1023); float s = 0.f; for (int k = c; k < DFF; k += 1024) s += bf2f(A_[r * DFF + k]) + 2.0f * bf2f(U_[r * DFF + k]); YR[i] = s; }
        return;
    }

    {
        const bf16_t* A16 = (const bf16_t*)(ws + WS_A16); bf16_t* U16 = (bf16_t*)(ws + WS_U16);
        const float* cw = a.in[I_CONVW]; const float* cb = a.in[I_CONVB]; const float* sc = a.in[I_SCONV];
        const int ox = C.xcd, orank = C.rank, onloc = C.nloc, onrows = 2048 + (ox < 2 ? 256 : 0);
        for (int i = orank * 512 + fresh_tid(); i < onrows * (DFF / 8); i += onloc * 512) {
            const int l = i / (DFF / 8), c8 = (i % (DFF / 8)) * 8; const int row = l < 2048 ? ox * 2048 + l : MP + ox * 256 + (l - 2048);
            const u32x4 a2 = *(const u32x4*)(A16 + (size_t)row * DFF + c8); const u32x4 uu = *(const u32x4*)(U16 + (size_t)row * DFF + c8);
            float x0[8], x1[8];
            if (row < MP) {
                const int t = row & (SEQ - 1);
                u32x4 p1 = (u32x4){0u, 0u, 0u, 0u}, p0 = p1;
                if (t >= 1) p1 = *(const u32x4*)(A16 + (size_t)(row - 1) * DFF + c8);
                if (t >= 2) p0 = *(const u32x4*)(A16 + (size_t)(row - 2) * DFF + c8);
                _Pragma("unroll") for (int e = 0; e < 4; ++e) { x1[2 * e] = bflo(p1[e]); x1[2 * e + 1] = bfhi(p1[e]); x0[2 * e] = bflo(p0[e]); x0[2 * e + 1] = bfhi(p0[e]); }
            } else {
                const int j = row & 3, bb = (row - MP) >> 2; const float* sb = sc + (size_t)bb * 2 * DFF + c8;
                if (j >= 1) { const u32x4 p1 = *(const u32x4*)(A16 + (size_t)(row - 1) * DFF + c8); _Pragma("unroll") for (int e = 0; e < 4; ++e) { x1[2 * e] = bflo(p1[e]); x1[2 * e + 1] = bfhi(p1[e]); } }
                else _Pragma("unroll") for (int e = 0; e < 8; ++e) x1[e] = sb[DFF + e];
                if (j >= 2) { const u32x4 p0 = *(const u32x4*)(A16 + (size_t)(row - 2) * DFF + c8); _Pragma("unroll") for (int e = 0; e < 4; ++e) { x0[2 * e] = bflo(p0[e]); x0[2 * e + 1] = bfhi(p0[e]); } }
                else _Pragma("unroll") for (int e = 0; e < 8; ++e) x0[e] = sb[(size_t)j * DFF + e];
            }
            float r[8];
#pragma unroll
            for (int e = 0; e < 8; ++e) {
                const float x2 = (e & 1) ? bfhi(a2[e >> 1]) : bflo(a2[e >> 1]); const float uv = (e & 1) ? bfhi(uu[e >> 1]) : bflo(uu[e >> 1]);
                const float cv = cb[c8 + e] + cw[c8 + e] * x0[e] + cw[DFF + c8 + e] * x1[e] + cw[2 * DFF + c8 + e] * x2;
                r[e] = gelu_as(cv) * uv;
            }
            u32x4 o; o.x = cvt_pk(r[0], r[1]); o.y = cvt_pk(r[2], r[3]); o.z = cvt_pk(r[4], r[5]); o.w = cvt_pk(r[6], r[7]);
            *(u32x4*)(U16 + (size_t)row * DFF + c8) = o;
        }
    }
    GRID_BAR();
    if (a.stop == 8) {
        const bf16_t* U_ = (const bf16_t*)(ws + WS_U16); const size_t gt = (size_t)C.bid * 512 + fresh_tid();
        for (size_t i = gt; i < (size_t)MT * 1024; i += GT) { const size_t r = i >> 10; const int c = (int)(i & 1023); float s = 0.f; for (int k = c; k < DFF; k += 1024) s += bf2f(U_[r * DFF + k]); YR[i] = s; }
        return;
    }

    for (int rr_ = 0; rr_ <= ((a.pad >> 8) & 1); ++rr_) {
    {
        pg8::Gemm g{(const bf16_t*)(ws + WS_U16), (const bf16_t*)(ws + WS_WDOWN), MT, 1024, DFF, DFF}; pg8::SplitOrder S; S.init(DFF, C.G, C.bid, 11);
        pg8::EpiFfn2 E{(const bf16_t*)(ws + WS_XH), YR, (float*)(ws + WS_A16)};
        pg8::gemm_phase<pg8::EpiFfn2, pg8::SplitOrder, true, true>(C.lds, g, S, E);
    }
    GRID_BAR();
    }
    if (a.stop == 9) return;

    { const int lane = fresh_tid() & 63; const int ox = C.xcd, orank = C.rank, onloc = C.nloc, onr = own_nrows(ox);
      for (int l = orank * 8 + C.wave; l < onr; l += onloc * 8) { const int row = own_row(ox, l);
          if (row < MP) ln_row(YR + (size_t)row * 1024, nullptr, YR + (size_t)row * 1024, a.in[I_LN2G], a.in[I_LN2B], lane);
          else ln_row(nullptr, nullptr, YR + (size_t)row * 1024, a.in[I_LN2G], a.in[I_LN2B], lane, (const float*)(ws + WS_A16) + (size_t)(row - MP) * 1024, 11, nullptr, (const bf16_t*)(ws + WS_XH) + (size_t)row * 1024); } }
}

extern "C" void kernel_launch(void* const* d_in, const int* in_sizes, int n_in, void* d_out, int out_size, void* d_ws, size_t ws_size, hipStream_t stream) {
    static int grid = 0;
    if (grid == 0) {
        if (n_in != 28 || (size_t)out_size != O_END || ws_size < WS_END) { fprintf(stderr, "kernel_launch: unexpected problem: n_in %d out %d ws %zu\n", n_in, out_size, ws_size); grid = -1; return; }
        int dev = 0, cus = 0, per_cu = 0;
        (void)hipGetDevice(&dev);
        (void)hipDeviceGetAttribute(&cus, hipDeviceAttributeMultiprocessorCount, dev);
        (void)hipFuncSetAttribute((const void*)fwd_kernel, hipFuncAttributeMaxDynamicSharedMemorySize, LDS_BYTES);
        (void)hipOccupancyMaxActiveBlocksPerMultiprocessor(&per_cu, (const void*)fwd_kernel, 512, LDS_BYTES);
        if (per_cu < 1) per_cu = 1;
        grid = cus * per_cu;
        fprintf(stderr, "kernel_launch: grid %d (cus %d x %d) ws %zu\n", grid, cus, per_cu, ws_size);
    }
    if (grid < 0) return;
    (void)hipMemsetAsync((char*)d_ws + WS_CTL, 0, CTL_BYTES, stream);
    Args a{};
    for (int i = 0; i < 28; ++i) a.in[i] = (const float*)d_in[i];
    a.out = (float*)d_out; a.ws = (unsigned char*)d_ws; a.stop = STOP_RT; a.pad = REP_MASK;
    void* args[] = {&a};
    hipError_t e = hipLaunchCooperativeKernel((const void*)fwd_kernel, dim3(grid), dim3(512), args, LDS_BYTES, stream);
    if (e != hipSuccess) fprintf(stderr, "kernel_launch: cooperative launch failed: %s (grid %d)\n", hipGetErrorString(e), grid);
}
```

```cpp
#include <hip/hip_runtime.h>
#include <hip/hip_cooperative_groups.h>
#include <cstdio>
#include <cstdint>
namespace cg = cooperative_groups;

constexpr int DM = 1024, NB = 8, SEQ = 2048, DB = 128, DSEQ = 4;
constexpr int MP = NB * SEQ, MS = DB * DSEQ, MT = MP + MS;
constexpr int INC = 5632, DFF = 2816, MEML = 256;
constexpr float DN_ALPHA = 1.189207115002721f;
constexpr float LN_EPS = 1e-5f, RMS_EPS = 1e-6f;
constexpr size_t O_Y = 0, O_POOLP = 17301504, O_HGP = 17332224, O_CONVP = 17856512, O_MEMK = 17901568, O_MEMV = 18425856,
                 O_POOLS = 18950144, O_HGS = 19441664, O_CONVS = 27830272, O_END = 28551168;
constexpr size_t OY_LF = 0, OY_Q = 8650752, OY_KK = 12976128;
constexpr size_t MiB = 1u << 20;
constexpr size_t WS_CTL = 0, CTL_BYTES = 32768, WS_LBT = 65536;
constexpr size_t WS_WGU = 1 * MiB, WS_WDOWN = 12 * MiB, WS_WOUT = 18 * MiB, WS_WBR = 20 * MiB;
constexpr size_t WS_XH = 22 * MiB;
constexpr size_t WS_GATE = 55 * MiB;
constexpr size_t WS_UA = 154 * MiB;
constexpr size_t WS_V = WS_UA + 17301504, WS_G = WS_V + 17301504, WS_QC = WS_G + 17301504;
constexpr size_t WS_WIN = WS_QC + 8650752;
constexpr size_t WS_WMEM = WS_WIN + 11534336, WS_MEMH = WS_WMEM + 1048576;
constexpr size_t WS_OB = WS_WIN;
constexpr size_t WS_A16 = 55 * MiB, WS_U16 = 146 * MiB;
constexpr size_t WS_END = 256 * MiB;
static_assert(WS_MEMH + 4194304 <= WS_END && WS_OB + 34603008 <= WS_END && WS_U16 + 95158272 <= WS_END && WS_A16 + 95158272 <= WS_U16, "ws map");
static_assert(WS_XH + 34603008 <= WS_GATE && WS_GATE + 103809024 <= WS_UA, "ws map 2");
constexpr int LDS_BYTES = 147456;

#define LAS __attribute__((address_space(3)))
typedef unsigned short bf16_t;
typedef short bf16x8 __attribute__((ext_vector_type(8)));
typedef float f32x4 __attribute__((ext_vector_type(4)));
typedef float f32x2 __attribute__((ext_vector_type(2)));
typedef unsigned u32x4 __attribute__((ext_vector_type(4)));
typedef unsigned u32x2 __attribute__((ext_vector_type(2)));

__device__ __forceinline__ unsigned cvt_pk(float lo, float hi) { unsigned r; asm volatile("v_cvt_pk_bf16_f32 %0, %1, %2" : "=v"(r) : "v"(lo), "v"(hi)); return r; }
__device__ __forceinline__ bf16_t f2bf(float f) { return (bf16_t)(cvt_pk(f, 0.f) & 0xffffu); }
__device__ __forceinline__ float bf2f(unsigned h) { return __uint_as_float(h << 16); }
__device__ __forceinline__ float bflo(unsigned w) { return __uint_as_float(w << 16); }
__device__ __forceinline__ float bfhi(unsigned w) { return __uint_as_float(w & 0xffff0000u); }
__device__ __forceinline__ u32x2 pk4(f32x4 v) { u32x2 r; r.x = cvt_pk(v[0], v[1]); r.y = cvt_pk(v[2], v[3]); return r; }
__device__ __forceinline__ f32x4 unpk4(u32x2 w) { return (f32x4){bflo(w.x), bfhi(w.x), bflo(w.y), bfhi(w.y)}; }
__device__ __forceinline__ void st8_coh(void* p, u32x2 v) { __hip_atomic_store((unsigned long long*)p, ((unsigned long long)v.y << 32) | v.x, __ATOMIC_RELAXED, __HIP_MEMORY_SCOPE_SYSTEM); }
__device__ __forceinline__ float sigmoidf_(float x) { return __builtin_amdgcn_rcpf(1.0f + __builtin_amdgcn_exp2f(x * -1.44269504088896f)); }
__device__ __forceinline__ float wave_sum(float v) {
#pragma unroll
    for (int o = 1; o < 64; o <<= 1) v += __shfl_xor(v, o);
    return v;
}

struct Args {
    const float* in[28];
    float* out; unsigned char* ws;
    int stop, pad;
};
#ifndef STOP_RT
#define STOP_RT 99
#endif
#ifndef REP_MASK
#define REP_MASK 0
#endif
enum { I_XP = 0, I_XS, I_SPOOL, I_SHG, I_SCONV, I_CK, I_CV, I_MEMP, I_LB, I_WIN, I_WGRP, I_PSCALE, I_HGG, I_WMK, I_WMV, I_WBP, I_WBH, I_WBM,
       I_WOUT, I_LN1G, I_LN1B, I_WGATE, I_WUP, I_CONVW, I_CONVB, I_WDOWN, I_LN2G, I_LN2B };

namespace pg8 {
#define PG8_LAS __attribute__((address_space(3)))
typedef unsigned short bf16_t;
typedef short bf16x8 __attribute__((ext_vector_type(8)));
typedef float f32x4 __attribute__((ext_vector_type(4)));
typedef unsigned u32x4 __attribute__((ext_vector_type(4)));
constexpr int BM = 256, BK = 64, HALF = 128, HTB = HALF * BK * 2  , STAGE_BYTES = 8 * HTB, NXCD = 8, WGM = 8;

__host__ __device__ __forceinline__ int lds_byte(int r, int c) { const int st = (r >> 4) * 2 + (c >> 5), rr = r & 15, cc = c & 31, ob = rr * 64 + cc * 2; return st * 1024 + (ob ^ (((ob >> 9) & 1) << 5)); }
__host__ __device__ __forceinline__ void stage_rc(int b, int& R, int& C) { const int st = b / 1024, sb = b % 1024, swz = sb ^ (((sb >> 9) & 1) << 5); R = (st >> 1) * 16 + swz / 64; C = (st & 1) * 32 + (swz % 64) / 2; }
__host__ __device__ __forceinline__ int perm32(int rho) { const int n = rho >> 4, i = rho & 15; return 8 * (i >> 2) + 4 * n + (i & 3); }

struct Unit { int pm, pn, k0, nt, pr, ps; };
struct Gemm { const bf16_t* A; const bf16_t* Bt; int M, N, K, ld; };

struct StaticOrder {
    int nM, nN, nwg, G, c;
    __host__ __device__ void init(int M, int N, int G_, int c_) { nM = M / BM; nN = N / BM; nwg = nM * nN; G = G_; c = c_; }
    __host__ __device__ bool next(int i, Unit& u) const {
        const long L = (long)i * G + c; if (L >= nwg) return false;
        int wgid = (int)L; { const int q = nwg / NXCD, r = nwg % NXCD, xcd = wgid % NXCD, off = wgid / NXCD; wgid = (xcd < r ? xcd * (q + 1) : r * (q + 1) + (xcd - r) * q) + off; }
        const int nig = WGM * nN, gid = wgid / nig, fm = gid * WGM, gsz = (nM - fm) < WGM ? (nM - fm) : WGM;
        u.pm = fm + ((wgid % nig) % gsz); u.pn = (wgid % nig) / gsz; u.k0 = 0; u.nt = 0; u.pr = u.pm; u.ps = 0; return true;
    }
    __device__ __forceinline__ void a_ready(const Unit&) const {}
    __device__ __forceinline__ void done(const Unit&) const {}
};

struct XcdOrder {
    int nN, nloc, x, r, npm, mode;
    __host__ __device__ void init(int M, int N, int G_, int c_) { nN = N / BM; nloc = G_ >> 3; x = c_ & 7; r = c_ >> 3; mode = (M == 2048) ? 1 : 0; npm = mode ? 1 : (8 + (x < 2 ? 1 : 0)); }
    __host__ __device__ void own(int x_, int r_, int nloc_) { x = x_; r = r_; nloc = nloc_; npm = mode ? 1 : (8 + (x < 2 ? 1 : 0)); }
    __host__ __device__ bool next(int i, Unit& u) const {
        const int idx = i * nloc + r; if (idx >= npm * nN) return false;
        const int k = idx % npm; u.pn = idx / npm; u.pm = mode ? x : (k < 8 ? x * 8 + k : 64 + x); u.k0 = 0; u.nt = 0; u.pr = u.pm; u.ps = 0; return true;
    }
    __device__ __forceinline__ void a_ready(const Unit&) const {}
    __device__ __forceinline__ void done(const Unit&) const {}
};

struct SplitOrder {
    StaticOrder P; int c, S, ntS, JB;
    __host__ __device__ void init(int K, int G_, int c_, int S_, int JB_ = 0) { P.init(16384, 1024, G_, c_); c = c_; S = S_; ntS = (K / S_) / BK; JB = JB_; }
    __host__ __device__ bool next(int i, Unit& u) const {
        Unit t; const bool okp = P.next(0, t);
        const int nJ = JB ? 3 : 1; const bool first = i == 0, shortu = (i == 1) && (c < 8 * S * nJ);
        if (!((first && okp) || shortu)) return false;
        const int J = c / (8 * S), cc = c % (8 * S), rem = cc % (4 * S), s = cc / (4 * S);
        u.pr = first ? t.pm : 64 + s; u.pm = first ? t.pm : (JB ? 66 + 2 * J + s : 64 + s); u.pn = first ? t.pn : rem / S;
        u.k0 = first ? 0 : (rem % S) * ntS * BK; u.nt = first ? 0 : ntS; u.ps = first ? 0 : J * S + rem % S; return true;
    }
    __device__ __forceinline__ void a_ready(const Unit&) const {}
    __device__ __forceinline__ void done(const Unit&) const {}
};

struct BranchOrder {
    StaticOrder P; int c;
    __host__ __device__ void init(int G_, int c_) { P.init(16384, 1024, G_, c_); c = c_; }
    __host__ __device__ bool next(int i, Unit& u) const {
        Unit t; const bool okp = P.next(0, t);
        const bool prompt = i < 3, samp = (i == 3) && (c < 24);
        if (!((prompt && okp) || samp)) return false;
        const int s = c / 3, J = prompt ? i : c % 3;
        const int pm = prompt ? t.pm : 64 + s / 4;
        u.pm = pm; u.pr = pm; u.pn = prompt ? t.pn : s % 4; u.ps = prompt ? 0 : 1;
        u.k0 = J == 0 ? 0 : (J == 1 ? 256 : 768); u.nt = J == 1 ? 8 : 4; return true;
    }
    __device__ __forceinline__ void a_ready(const Unit&) const {}
    __device__ __forceinline__ void done(const Unit&) const {}
};

#define EPI_LOOP(...) \
    _Pragma("unroll") for (int ai = 0; ai < 2; ++ai) _Pragma("unroll") for (int m = 0; m < 4; ++m) { const int row = row0 + ai * 128 + m * 16; \
    _Pragma("unroll") for (int bj = 0; bj < 2; ++bj) _Pragma("unroll") for (int n = 0; n < 2; ++n) { const int col = col0 + bj * 128 + n * 16; const f32x4 v = acc[ai][bj][m][n]; __VA_ARGS__ } asm volatile("" ::: "memory"); }
#define EPI_LOOPG(GROUP, ...) \
    _Pragma("unroll") for (int ai = 0; ai < 2; ++ai) _Pragma("unroll") for (int m = 0; m < 4; ++m) { const int row = row0 + ai * 128 + m * 16; \
    _Pragma("unroll") for (int bj = 0; bj < 2; ++bj) _Pragma("unroll") for (int n = 0; n < 2; ++n) { const int col = col0 + bj * 128 + n * 16; const f32x4 v = acc[ai][bj][m][n]; __VA_ARGS__ } if ((m % (GROUP)) == (GROUP) - 1) asm volatile("" ::: "memory"); }

struct EpiIn {
    static constexpr bool PERM = false, AFTER_DRAIN = false;
    float* UA; bf16_t* Q; float* LF; bf16_t* KK; bf16_t* V; bf16_t* G; bf16_t* QC; bf16_t* GATE; const float* lbl;
    __device__ __forceinline__ void operator()(const f32x4 (&acc)[2][2][4][2], const Unit& u, int wr, int wc, int fr, int fq) const {
        const int row0 = u.pm * BM + wr * 64 + fr, colt = u.pn * BM, col0 = colt + wc * 32 + 4 * fq;
        if (colt < 256) {
            EPI_LOOP( *(f32x4*)(UA + (size_t)row * 256 + col) = v; )
        } else if (colt < 768) {
            EPI_LOOP( f32x4 o; _Pragma("unroll") for (int e = 0; e < 4; ++e) o[e] = v[e] * sigmoidf_(v[e]); *(u32x2*)(Q + (size_t)row * 512 + (col - 256)) = pk4(o); )
        } else if (colt < 1280) {
            EPI_LOOP( f32x4 lf, kk; const f32x4 lb = *(const f32x4*)(lbl + (col - 768));
                _Pragma("unroll") for (int e = 0; e < 4; ++e) { const float s = sigmoidf_(v[e]); lf[e] = __logf(lb[e] + (1.0f - lb[e]) * s); kk[e] = (1.0f - lb[e]) * (1.0f - s); }
                *(f32x4*)(LF + (size_t)row * 512 + (col - 768)) = lf; *(u32x2*)(KK + (size_t)row * 512 + (col - 768)) = pk4(kk); )
        } else if (colt < 1792) {
            EPI_LOOP( *(u32x2*)(V + (size_t)row * 512 + (col - 1280)) = pk4(v); )
        } else if (colt < 2304) {
            EPI_LOOP( f32x4 o; _Pragma("unroll") for (int e = 0; e < 4; ++e) o[e] = v[e] * sigmoidf_(v[e]); *(u32x2*)(G + (size_t)row * 512 + (col - 1792)) = pk4(o); )
        } else if (colt < 2560) {
            EPI_LOOP( *(u32x2*)(QC + (size_t)row * 256 + (col - 2304)) = pk4(v * 0.125f); )
        } else {
            EPI_LOOP( f32x4 o; _Pragma("unroll") for (int e = 0; e < 4; ++e) o[e] = sigmoidf_(v[e]); *(u32x2*)(GATE + (size_t)row * 3072 + (col - 2560)) = pk4(o); )
        }
    }
};
struct EpiMem {
    static constexpr bool PERM = false, AFTER_DRAIN = false;
    float* KO; float* VO;
    __device__ __forceinline__ void operator()(const f32x4 (&acc)[2][2][4][2], const Unit& u, int wr, int wc, int fr, int fq) const {
        const int row0 = u.pm * BM + wr * 64 + fr, colt = u.pn * BM, col0 = wc * 32 + 4 * fq;
        float* O = colt == 0 ? KO : VO;
        EPI_LOOP( *(f32x4*)(O + (size_t)row * 256 + col) = v; )
    }
};
struct EpiBr {
    static constexpr bool PERM = false, AFTER_DRAIN = false;
    const bf16_t* GATE; bf16_t* MH;
    __device__ __forceinline__ void operator()(const f32x4 (&acc)[2][2][4][2], const Unit& u, int wr, int wc, int fr, int fq) const {
        const int row0 = u.pm * BM + wr * 64 + fr, col0 = u.pn * BM + wc * 32 + 4 * fq;
        const int J = u.k0 >= 768 ? 2 : (u.k0 >= 256 ? 1 : 0); const bf16_t* gj = GATE + J * 1024;
        if (u.ps) { bf16_t* pb = MH + (size_t)MT * 1024 + (size_t)J * (512 * 1024) - (size_t)MP * 1024;
            EPI_LOOPG(2, const f32x4 g = unpk4(*(const u32x2*)(gj + (size_t)row * 3072 + col)); *(u32x2*)(pb + (size_t)row * 1024 + col) = pk4(g * v); ) }
        else if (J == 0) { EPI_LOOPG(2, const f32x4 g = unpk4(*(const u32x2*)(gj + (size_t)row * 3072 + col)); *(u32x2*)(MH + (size_t)row * 1024 + col) = pk4(g * v); ) }
        else { EPI_LOOPG(2, const f32x4 g = unpk4(*(const u32x2*)(gj + (size_t)row * 3072 + col)); u32x2* mp = (u32x2*)(MH + (size_t)row * 1024 + col); *mp = pk4(unpk4(*mp) + g * v); ) }
    }
};
struct EpiOut {
    static constexpr bool PERM = false, AFTER_DRAIN = false;
    const float* xp; const float* xs; float* HP; float* PART;
    __device__ __forceinline__ void operator()(const f32x4 (&acc)[2][2][4][2], const Unit& u, int wr, int wc, int fr, int fq) const {
        const int row0 = u.pr * BM + wr * 64 + fr, col0 = u.pn * BM + wc * 32 + 4 * fq;
        const float* xb = (u.pr * BM < MP) ? xp : (xs - (size_t)MP * 1024);
        if (u.nt) {
            float* pp = PART + (size_t)u.ps * (512 * 1024) - (size_t)MP * 1024;
            EPI_LOOP( *(f32x4*)(pp + (size_t)row * 1024 + col) = v; )
        } else {
            EPI_LOOPG(2, const f32x4 x = *(const f32x4*)(xb + (size_t)row * 1024 + col); *(f32x4*)(HP + (size_t)row * 1024 + col) = x * DN_ALPHA + v; )
        }
    }
};
struct EpiFfn1 {
    static constexpr bool PERM = false, AFTER_DRAIN = false;
    bf16_t* A16; bf16_t* U16; float* convp; float* convs;
    __device__ __forceinline__ void operator()(const f32x4 (&acc)[2][2][4][2], const Unit& u, int wr, int wc, int fr, int fq) const {
        const int row0 = u.pm * BM + wr * 64 + fr, colt = u.pn * BM, col0 = colt + wc * 32 + 4 * fq;
        if (colt < DFF) {
            EPI_LOOP( *(u32x2*)(A16 + (size_t)row * DFF + col) = pk4(v);
                if (row < MP) { const int t = row & (SEQ - 1); if (t >= SEQ - 2) *(f32x4*)(convp + ((size_t)(row >> 11) * 2 + (t - (SEQ - 2))) * DFF + col) = v; }
                else { const int j = row & 3; if (j >= 2) *(f32x4*)(convs + ((size_t)((row - MP) >> 2) * 2 + (j - 2)) * DFF + col) = v; } )
        } else {
            EPI_LOOP( *(u32x2*)(U16 + (size_t)row * DFF + (col - DFF)) = pk4(v); )
        }
    }
};
struct EpiFfn2 {
    static constexpr bool PERM = false, AFTER_DRAIN = false;
    const bf16_t* H; float* YP; float* PART;
    __device__ __forceinline__ void operator()(const f32x4 (&acc)[2][2][4][2], const Unit& u, int wr, int wc, int fr, int fq) const {
        const int row0 = u.pr * BM + wr * 64 + fr, col0 = u.pn * BM + wc * 32 + 4 * fq;
        if (u.nt) {
            float* pp = PART + (size_t)u.ps * (512 * 1024) - (size_t)MP * 1024;
            EPI_LOOP( *(f32x4*)(pp + (size_t)row * 1024 + col) = v; )
        } else {
            EPI_LOOPG(4, const f32x4 h = unpk4(*(const u32x2*)(H + (size_t)row * 1024 + col)); *(f32x4*)(YP + (size_t)row * 1024 + col) = h * DN_ALPHA + v; )
        }
    }
};

template <class Epi, class Sched, bool ALIGN_EPI = false, bool SP2 = false>
__device__ __forceinline__ void gemm_phase(PG8_LAS unsigned char* lds, const Gemm g, const Sched& S, const Epi& E) {
    int tid_ = threadIdx.x; asm volatile("" : "+v"(tid_));
    const int tid = tid_, wid = __builtin_amdgcn_readfirstlane(tid >> 6), lane = tid & 63, wr = wid >> 2, wc = wid & 3, fr = lane & 15, fq = lane >> 4;
    const int K = g.ld, nt = g.K / BK;
    unsigned voffA[2], voffB[2];
#pragma unroll
    for (int i = 0; i < 2; ++i) { int R, C; stage_rc(tid * 16 + i * 8192, R, C); const int Rb = Epi::PERM ? ((R & ~31) + perm32(R & 31)) : R;
        voffA[i] = (unsigned)(R * K + C) * 2u; voffB[i] = (unsigned)(Rb * K + C) * 2u; }
    const size_t kstep = (size_t)(BK * 2);
    const size_t hstep = (size_t)HALF * K * 2;
    const size_t tstep = 2 * hstep;
    const unsigned ldsw = (unsigned)wid * 1024u;
    const int aoff = lds_byte(wr * 64 + fr, fq * 8), boff = lds_byte(wc * 32 + fr, fq * 8);
#define PG8_SA(b, h) (((b) * 2 + (h)) * HTB)
#define PG8_SB(b, h) ((4 + (b) * 2 + (h)) * HTB)
#define PG8_STAGE(bufoff, gbase, voff) do { _Pragma("unroll") for (int _i = 0; _i < 2; ++_i) \
        __builtin_amdgcn_global_load_lds((const unsigned*)((const char*)(gbase) + (voff)[_i]), (PG8_LAS unsigned*)(lds + (bufoff) + ldsw + _i * 8192), 16, 0, 0); } while (0)
#define PG8_LDA(dst, b, h) do { _Pragma("unroll") for (int m = 0; m < 4; ++m) _Pragma("unroll") for (int k = 0; k < 2; ++k) dst[m][k] = *(const PG8_LAS bf16x8*)(lds + PG8_SA(b, h) + aoff + m * 2048 + k * 1024); } while (0)
#define PG8_LDB(dst, b, h) do { _Pragma("unroll") for (int n = 0; n < 2; ++n) _Pragma("unroll") for (int k = 0; k < 2; ++k) dst[n][k] = *(const PG8_LAS bf16x8*)(lds + PG8_SB(b, h) + boff + n * 2048 + k * 1024); } while (0)
#define PG8_MMA(ai, bj, At, Bt) do { __builtin_amdgcn_s_setprio(1); _Pragma("unroll") for (int m = 0; m < 4; ++m) _Pragma("unroll") for (int n = 0; n < 2; ++n) _Pragma("unroll") for (int k = 0; k < 2; ++k) \
        acc[ai][bj][m][n] = __builtin_amdgcn_mfma_f32_16x16x32_bf16(Bt[n][k], At[m][k], acc[ai][bj][m][n], 0, 0, 0); __builtin_amdgcn_s_setprio(0); } while (0)
#define PG8_WAIT_V(n) asm volatile("s_waitcnt vmcnt(" #n ")" ::: "memory")
#define PG8_WAIT_L(n) asm volatile("s_waitcnt lgkmcnt(" #n ")" ::: "memory")
#define PG8_BAR __builtin_amdgcn_s_barrier()
#define PG8_SCHED __builtin_amdgcn_sched_barrier(0)
    Unit cur, nxt; int ui = 0;
    if (!S.next(0, cur)) return;
    f32x4 acc[2][2][4][2];
#pragma unroll
    for (int a = 0; a < 2; ++a)
#pragma unroll
        for (int b = 0; b < 2; ++b)
#pragma unroll
            for (int m = 0; m < 4; ++m)
#pragma unroll
                for (int n = 0; n < 2; ++n) acc[a][b][m][n] = (f32x4){0.f, 0.f, 0.f, 0.f};
    bf16x8 At[4][2], B0[2][2], B1[2][2];
    const char* cA = (const char*)g.A + (size_t)cur.pm * tstep + (size_t)cur.k0 * 2; const char* cB = (const char*)g.Bt + (size_t)cur.pn * tstep + (size_t)cur.k0 * 2;
    S.a_ready(cur);
    if constexpr (SP2) {
        PG8_STAGE(PG8_SB(0, 0), cB, voffB); PG8_STAGE(PG8_SB(0, 1), cB + hstep, voffB); PG8_STAGE(PG8_SA(0, 0), cA, voffA); PG8_STAGE(PG8_SA(0, 1), cA + hstep, voffA);
        if (wr == 1) PG8_BAR;
        PG8_WAIT_V(2); PG8_BAR;
        PG8_STAGE(PG8_SB(1, 0), cB + kstep, voffB); PG8_STAGE(PG8_SA(1, 0), cA + kstep, voffA); PG8_STAGE(PG8_SB(1, 1), cB + hstep + kstep, voffB);
        PG8_WAIT_V(6); PG8_BAR;
    } else {
        PG8_STAGE(PG8_SB(0, 0), cB, voffB); PG8_STAGE(PG8_SA(0, 0), cA, voffA); PG8_STAGE(PG8_SB(0, 1), cB + hstep, voffB); PG8_STAGE(PG8_SA(0, 1), cA + hstep, voffA);
        if (wr == 1) PG8_BAR;
        PG8_WAIT_V(4); PG8_BAR;
        PG8_STAGE(PG8_SB(1, 0), cB + kstep, voffB); PG8_STAGE(PG8_SA(1, 0), cA + kstep, voffA); PG8_STAGE(PG8_SB(1, 1), cB + hstep + kstep, voffB);
        PG8_WAIT_V(6); PG8_BAR;
    }
    for (;;) {
        const bool has_next = S.next(ui + 1, nxt);
        const char* nA = has_next ? (const char*)g.A + (size_t)nxt.pm * tstep + (size_t)nxt.k0 * 2 : cA; const char* nB = has_next ? (const char*)g.Bt + (size_t)nxt.pn * tstep + (size_t)nxt.k0 * 2 : cB;
        const int unt = cur.nt ? cur.nt : nt;
        for (int t = 0; t < unt; t += 2) {
            const bool last = (t == unt - 2);
            const char* a1 = cA + (size_t)(t + 1) * kstep;
            const char* a2 = last ? nA : cA + (size_t)(t + 2) * kstep; const char* b2 = last ? nB : cB + (size_t)(t + 2) * kstep;
            const char* a3 = a2 + kstep; const char* b3 = b2 + kstep;
            if (last && has_next) S.a_ready(nxt);
            if constexpr (SP2) {
            PG8_LDB(B0, 0, 0); PG8_LDB(B1, 0, 1); PG8_SCHED; PG8_LDA(At, 0, 0); PG8_STAGE(PG8_SA(1, 1), a1 + hstep, voffA);
            PG8_WAIT_V(8); PG8_WAIT_L(0); PG8_BAR; PG8_MMA(0, 0, At, B0); PG8_MMA(0, 1, At, B1); PG8_BAR; PG8_SCHED;
            PG8_LDA(At, 0, 1); PG8_STAGE(PG8_SB(0, 0), b2, voffB); PG8_STAGE(PG8_SB(0, 1), b2 + hstep, voffB); PG8_STAGE(PG8_SA(0, 0), a2, voffA);
            PG8_WAIT_V(8); PG8_WAIT_L(0); PG8_BAR; PG8_MMA(1, 0, At, B0); PG8_MMA(1, 1, At, B1); PG8_BAR; PG8_SCHED;
            PG8_LDB(B0, 1, 0); PG8_LDB(B1, 1, 1); PG8_SCHED; PG8_LDA(At, 1, 0); PG8_STAGE(PG8_SA(0, 1), a2 + hstep, voffA);
            PG8_WAIT_V(8); PG8_WAIT_L(0); PG8_BAR; PG8_MMA(0, 0, At, B0); PG8_MMA(0, 1, At, B1); PG8_BAR; PG8_SCHED;
            PG8_LDA(At, 1, 1); PG8_STAGE(PG8_SB(1, 0), b3, voffB); PG8_STAGE(PG8_SB(1, 1), b3 + hstep, voffB); PG8_STAGE(PG8_SA(1, 0), a3, voffA);
            PG8_WAIT_V(8); PG8_WAIT_L(0); PG8_BAR; PG8_MMA(1, 0, At, B0); PG8_MMA(1, 1, At, B1); PG8_BAR; PG8_SCHED;
            } else {
            PG8_LDB(B0, 0, 0); PG8_SCHED; PG8_LDA(At, 0, 0); PG8_STAGE(PG8_SA(1, 1), a1 + hstep, voffA);
            PG8_WAIT_L(8); PG8_BAR; PG8_WAIT_L(0); PG8_MMA(0, 0, At, B0); PG8_BAR; PG8_SCHED;
            PG8_LDB(B1, 0, 1); PG8_STAGE(PG8_SB(0, 0), b2, voffB);
            PG8_BAR; PG8_WAIT_L(0); PG8_MMA(0, 1, At, B1); PG8_BAR;
            PG8_LDA(At, 0, 1); PG8_STAGE(PG8_SA(0, 0), a2, voffA);
            PG8_BAR; PG8_WAIT_L(0); PG8_MMA(1, 0, At, B0); PG8_BAR; PG8_SCHED;
            PG8_STAGE(PG8_SB(0, 1), b2 + hstep, voffB);
            PG8_WAIT_V(6); PG8_BAR; PG8_MMA(1, 1, At, B1); PG8_BAR;
            PG8_LDB(B0, 1, 0); PG8_SCHED; PG8_LDA(At, 1, 0); PG8_STAGE(PG8_SA(0, 1), a2 + hstep, voffA);
            PG8_WAIT_L(8); PG8_BAR; PG8_WAIT_L(0); PG8_MMA(0, 0, At, B0); PG8_BAR; PG8_SCHED;
            PG8_LDB(B1, 1, 1); PG8_STAGE(PG8_SB(1, 0), b3, voffB);
            PG8_BAR; PG8_WAIT_L(0); PG8_MMA(0, 1, At, B1); PG8_BAR;
            PG8_LDA(At, 1, 1); PG8_STAGE(PG8_SA(1, 0), a3, voffA);
            PG8_BAR; PG8_WAIT_L(0); PG8_MMA(1, 0, At, B0); PG8_BAR; PG8_SCHED;
            PG8_STAGE(PG8_SB(1, 1), b3 + hstep, voffB);
            PG8_WAIT_V(6); PG8_BAR; PG8_MMA(1, 1, At, B1); PG8_BAR;
            }
        }
        if constexpr (ALIGN_EPI) { if (wr == 0) PG8_BAR; }
        if constexpr (!Epi::AFTER_DRAIN) { E(acc, cur, wr, wc, fr, fq); S.done(cur); }
        if (!has_next) break;
#pragma unroll
        for (int a = 0; a < 2; ++a)
#pragma unroll
            for (int b = 0; b < 2; ++b)
#pragma unroll
                for (int m = 0; m < 4; ++m)
#pragma unroll
                    for (int n = 0; n < 2; ++n) acc[a][b][m][n] = (f32x4){0.f, 0.f, 0.f, 0.f};
        cur = nxt; cA = nA; cB = nB; ++ui;
        if constexpr (ALIGN_EPI) { if (wr == 1) PG8_BAR; }
    }
    PG8_WAIT_V(0);
    if constexpr (!ALIGN_EPI) { if (wr == 0) PG8_BAR; }
    PG8_BAR;
    if constexpr (Epi::AFTER_DRAIN) { E.fused(acc, cur, wr, wc, fr, fq, lds, wid, lane); S.done(cur); }
#undef PG8_SA
#undef PG8_SB
#undef PG8_STAGE
#undef PG8_LDA
#undef PG8_LDB
#undef PG8_MMA
#undef PG8_WAIT_V
#undef PG8_WAIT_L
#undef PG8_BAR
#undef PG8_SCHED
}
}

struct Ctx {
    LAS unsigned char* lds;
    int wave, G, bid, xcd, rank, nloc;
};
__device__ __forceinline__ int fresh_tid() { int t = threadIdx.x; asm volatile("" : "+v"(t)); return t; }
__device__ __forceinline__ int own_nrows(int x) { return 2048 + (x < 2 ? 256 : 0); }
__device__ __forceinline__ int own_row(int x, int l) { return l < 2048 ? x * 2048 + l : MP + x * 256 + (l - 2048); }
#define LDS_WAIT() asm volatile("s_waitcnt lgkmcnt(0)" ::: "memory")
__device__ __forceinline__ bf16x8 ldfrag(const LAS bf16_t* base, int stride, int row, int k0) { return *(const LAS bf16x8*)(base + row * stride + k0); }
#define MFMA16(a, b, c) __builtin_amdgcn_mfma_f32_16x16x32_bf16((a), (b), (c), 0, 0, 0)

__device__ __forceinline__ void p0_transpose_item(const float* W, int N, bf16_t* WT, int ldT, int row_off, int col_off, LAS float* scr, int item, int lane) {
    const int nblk = N / 32, kb = item / nblk, nb = item % nblk, k0 = 64 * kb, n0 = 32 * nb;
#pragma unroll 8
    for (int i = 0; i < 32; ++i) { const int kk = 2 * i + (lane >> 5); scr[kk * 33 + (lane & 31)] = W[(size_t)(k0 + kk) * N + n0 + (lane & 31)]; }
    LDS_WAIT(); asm volatile("" ::: "memory");
    const int c = lane & 7;
#pragma unroll
    for (int j = 0; j < 4; ++j) { const int n = (lane >> 3) + 8 * j; const LAS float* s = scr + (8 * c) * 33 + n;
        u32x4 o; o.x = cvt_pk(s[0 * 33], s[1 * 33]); o.y = cvt_pk(s[2 * 33], s[3 * 33]); o.z = cvt_pk(s[4 * 33], s[5 * 33]); o.w = cvt_pk(s[6 * 33], s[7 * 33]);
        *(u32x4*)(WT + (size_t)(row_off + n0 + n) * ldT + col_off + k0 + 8 * c) = o; }
    LDS_WAIT(); asm volatile("" ::: "memory");
}
__device__ __forceinline__ void cvt_rows(const float* src, bf16_t* dst, size_t n8, size_t gt, size_t GT) {
    for (size_t i = gt; i < n8; i += GT) { const f32x4 a = *(const f32x4*)(src + i * 8), b = *(const f32x4*)(src + i * 8 + 4);
        u32x4 o; o.x = cvt_pk(a[0], a[1]); o.y = cvt_pk(a[2], a[3]); o.z = cvt_pk(b[0], b[1]); o.w = cvt_pk(b[2], b[3]); *(u32x4*)(dst + i * 8) = o; }
}

__device__ __forceinline__ void p0_prep(const Ctx& C, const Args& a) {
    unsigned char* ws = a.ws;
    bf16_t* WinT = (bf16_t*)(ws + WS_WIN); bf16_t* WmemT = (bf16_t*)(ws + WS_WMEM); bf16_t* WbrT = (bf16_t*)(ws + WS_WBR); bf16_t* WoutT = (bf16_t*)(ws + WS_WOUT);
    bf16_t* WguT = (bf16_t*)(ws + WS_WGU); bf16_t* WdownT = (bf16_t*)(ws + WS_WDOWN);
    const int tid = fresh_tid(), lane = tid & 63;
    LAS float* scr = (LAS float*)(C.lds + C.wave * 16384);
    const int gw = C.bid * 8 + C.wave, NGW = C.G * 8;
    constexpr int I_IN = 16 * 176, I_MK = 16 * 8, I_BH = 8 * 32, I_BM = 4 * 32, I_OUT = 16 * 32, I_GT = 16 * 88, I_DN = 44 * 32;
    constexpr int NITEMS = I_IN + 2 * I_MK + I_BH + I_BM + I_OUT + 2 * I_GT + I_DN;
    for (int it = gw; it < NITEMS; it += NGW) {
        int r = it;
        if (r < I_IN) { p0_transpose_item(a.in[I_WIN], INC, WinT, 1024, 0, 0, scr, r, lane); continue; } r -= I_IN;
        if (r < I_MK) { p0_transpose_item(a.in[I_WMK], 256, WmemT, 1024, 0, 0, scr, r, lane); continue; } r -= I_MK;
        if (r < I_MK) { p0_transpose_item(a.in[I_WMV], 256, WmemT, 1024, 256, 0, scr, r, lane); continue; } r -= I_MK;
        if (r < I_BH) { p0_transpose_item(a.in[I_WBH], 1024, WbrT, 1024, 0, 256, scr, r, lane); continue; } r -= I_BH;
        if (r < I_BM) { p0_transpose_item(a.in[I_WBM], 1024, WbrT, 1024, 0, 768, scr, r, lane); continue; } r -= I_BM;
        if (r < I_OUT) { p0_transpose_item(a.in[I_WOUT], 1024, WoutT, 1024, 0, 0, scr, r, lane); continue; } r -= I_OUT;
        if (r < I_GT) { p0_transpose_item(a.in[I_WGATE], DFF, WguT, 1024, 0, 0, scr, r, lane); continue; } r -= I_GT;
        if (r < I_GT) { p0_transpose_item(a.in[I_WUP], DFF, WguT, 1024, DFF, 0, scr, r, lane); continue; } r -= I_GT;
        p0_transpose_item(a.in[I_WDOWN], 1024, WdownT, DFF, 0, 0, scr, r, lane);
    }
    const size_t gt = (size_t)C.bid * 512 + tid, GT = (size_t)C.G * 512;
    for (size_t i = gt; i < 256 * 1024; i += GT) {
        const int k = (int)(i >> 10), n = (int)(i & 1023), g = k >> 6;
        const float* wg = a.in[I_WGRP] + (size_t)k * 64; const float* sc = a.in[I_PSCALE] + g * 64; const float* wb = a.in[I_WBP] + (size_t)(g * 64) * 1024 + n;
        float s = 0.f;
#pragma unroll 8
        for (int d = 0; d < 64; ++d) s += wg[d] * sc[d] * wb[(size_t)d * 1024];
        WbrT[(size_t)n * 1024 + k] = f2bf(s);
    }
    if (gt < 512) { const float* l = a.in[I_LB]; ((float*)(ws + WS_LBT))[gt] = 1.0f / (1.0f + __expf(l[512 + gt] - l[gt])); }
    bf16_t* Xh = (bf16_t*)(ws + WS_XH);
#if defined(NAN_MEMKV)
    for (size_t i = gt; i < 2 * 524288; i += GT) ((unsigned*)(a.out + O_MEMK))[i] = 0x7fc00000u;
#endif
    {
        const int ox = C.xcd, orank = C.rank, onloc = C.nloc, onr = own_nrows(ox);
        for (int i = orank * 512 + tid; i < onr * 128; i += onloc * 512) { const int row = own_row(ox, i >> 7), g8 = (i & 127) * 8;
            const float* src = row < MP ? a.in[I_XP] + (size_t)row * 1024 + g8 : a.in[I_XS] + (size_t)(row - MP) * 1024 + g8;
            const f32x4 v0 = *(const f32x4*)src, v1 = *(const f32x4*)(src + 4);
            u32x4 o; o.x = cvt_pk(v0[0], v0[1]); o.y = cvt_pk(v0[2], v0[3]); o.z = cvt_pk(v1[0], v1[1]); o.w = cvt_pk(v1[2], v1[3]); *(u32x4*)(Xh + (size_t)row * 1024 + g8) = o; }
        for (int i = orank * 512 + tid; i < 256 * 128; i += onloc * 512) { const size_t e = ((size_t)(ox * 256 + (i >> 7))) * 1024 + (i & 127) * 8;
            const f32x4 v0 = *(const f32x4*)(a.in[I_MEMP] + e), v1 = *(const f32x4*)(a.in[I_MEMP] + e + 4);
            u32x4 o; o.x = cvt_pk(v0[0], v0[1]); o.y = cvt_pk(v0[2], v0[3]); o.z = cvt_pk(v1[0], v1[1]); o.w = cvt_pk(v1[2], v1[3]); *(u32x4*)((bf16_t*)(ws + WS_MEMH) + e) = o; }
    }
}

__device__ __forceinline__ void hgrn_prompt_unit(const Ctx& C, const Args& a, int unit) {
    const int b = unit >> 4, h = (unit >> 2) & 3, eq = unit & 3;
    const float* LF = a.out + OY_LF; const bf16_t* Q = (const bf16_t*)(a.out + OY_Q); const bf16_t* KK = (const bf16_t*)(a.out + OY_KK);
    const bf16_t* V = (const bf16_t*)(a.ws + WS_V); float* OB = (float*)(a.ws + WS_OB);
    LAS bf16_t* Qp = (LAS bf16_t*)C.lds;
    LAS bf16_t* Kp = Qp + 64 * 136;
    LAS bf16_t* KT = Kp + 64 * 136;
    LAS bf16_t* VT = KT + 128 * 72;
    LAS bf16_t* SC = VT + 32 * 72;
    LAS bf16_t* ST = SC + 64 * 72;
    LAS float* blast = (LAS float*)(ST + 32 * 136);
    LAS float* part = blast + 128;
    const int tid = fresh_tid(), lane = tid & 63, w = C.wave, l16 = lane & 15, q4 = lane >> 4;
    const int d = tid & 127, tq = tid >> 7;
    for (int i = tid; i < 32 * 136 / 2; i += 512) ((LAS unsigned*)ST)[i] = 0u;
    f32x4 sacc[2]; sacc[0] = (f32x4){0.f, 0.f, 0.f, 0.f}; sacc[1] = sacc[0];
    const int vt = tid >> 3, ve = (tid & 7) * 4;
    float lfr[16]; unsigned short qr[16], kr[16]; u32x2 vr;
#define HG_LOAD(cc) do { const int rb_ = b * SEQ + (cc) * 64; _Pragma("unroll") for (int i = 0; i < 16; ++i) { const size_t idx = (size_t)(rb_ + tq * 16 + i) * 512 + h * 128 + d; \
        lfr[i] = LF[idx]; qr[i] = Q[idx]; kr[i] = KK[idx]; } vr = *(const u32x2*)(V + (size_t)(rb_ + vt) * 512 + h * 128 + eq * 32 + ve); } while (0)
    HG_LOAD(0);
    for (int c = 0; c < SEQ / 64; ++c) {
        const int rbase = b * SEQ + c * 64;
        float bl[16], qv[16], kv[16]; float run = 0.f;
#pragma unroll
        for (int i = 0; i < 16; ++i) { run += lfr[i]; bl[i] = run; qv[i] = bf2f(qr[i]); kv[i] = bf2f(kr[i]); }
        const u32x2 vraw = vr;
        if (c + 1 < SEQ / 64) HG_LOAD(c + 1);
        part[tq * 128 + d] = run;
        __syncthreads();
        float off = 0.f, tot = 0.f;
#pragma unroll
        for (int p = 0; p < 4; ++p) { const float x = part[p * 128 + d]; tot += x; if (p < tq) off += x; }
        if (tq == 0) blast[d] = tot;
        unsigned ktp[8];
#pragma unroll
        for (int i = 0; i < 16; i += 2) {
            const float b0 = bl[i] + off, b1 = bl[i + 1] + off;
            Qp[(tq * 16 + i) * 136 + d] = f2bf(qv[i] * __expf(b0)); Qp[(tq * 16 + i + 1) * 136 + d] = f2bf(qv[i + 1] * __expf(b1));
            Kp[(tq * 16 + i) * 136 + d] = f2bf(kv[i] * __expf(-b0)); Kp[(tq * 16 + i + 1) * 136 + d] = f2bf(kv[i + 1] * __expf(-b1));
            ktp[i >> 1] = cvt_pk(kv[i] * __expf(tot - b0), kv[i + 1] * __expf(tot - b1));
        }
        *(LAS u32x4*)(KT + d * 72 + tq * 16) = (u32x4){ktp[0], ktp[1], ktp[2], ktp[3]};
        *(LAS u32x4*)(KT + d * 72 + tq * 16 + 8) = (u32x4){ktp[4], ktp[5], ktp[6], ktp[7]};
        VT[(ve + 0) * 72 + vt] = (bf16_t)(vraw.x & 0xffffu); VT[(ve + 1) * 72 + vt] = (bf16_t)(vraw.x >> 16);
        VT[(ve + 2) * 72 + vt] = (bf16_t)(vraw.y & 0xffffu); VT[(ve + 3) * 72 + vt] = (bf16_t)(vraw.y >> 16);
        __syncthreads();
#pragma unroll
        for (int bi = 0; bi < 2; ++bi) {
            const int blk = 2 * w + bi, tb = blk >> 2, sb = blk & 3;
            f32x4 acc = (f32x4){0.f, 0.f, 0.f, 0.f};
            if (sb <= tb) {
#pragma unroll
                for (int kk = 0; kk < 4; ++kk) acc = MFMA16(ldfrag(Kp, 136, sb * 16 + l16, kk * 32 + q4 * 8), ldfrag(Qp, 136, tb * 16 + l16, kk * 32 + q4 * 8), acc);
                const int t = tb * 16 + l16, s0 = sb * 16 + 4 * q4;
#pragma unroll
                for (int j = 0; j < 4; ++j) if (s0 + j > t) acc[j] = 0.f;
            }
            *(LAS u32x2*)(SC + (tb * 16 + l16) * 72 + sb * 16 + 4 * q4) = pk4(acc);
        }
        __syncthreads();
        {
            const int tb = w >> 1, eb = w & 1;
            f32x4 acc = (f32x4){0.f, 0.f, 0.f, 0.f};
#pragma unroll
            for (int kk = 0; kk < 2; ++kk) acc = MFMA16(ldfrag(VT, 72, eb * 16 + l16, kk * 32 + q4 * 8), ldfrag(SC, 72, tb * 16 + l16, kk * 32 + q4 * 8), acc);
#pragma unroll
            for (int kk = 0; kk < 4; ++kk) acc = MFMA16(ldfrag(ST, 136, eb * 16 + l16, kk * 32 + q4 * 8), ldfrag(Qp, 136, tb * 16 + l16, kk * 32 + q4 * 8), acc);
            *(f32x4*)(OB + (size_t)(rbase + tb * 16 + l16) * 512 + h * 128 + eq * 32 + eb * 16 + 4 * q4) = acc;
        }
        {
            const f32x4 bl4 = *(const LAS f32x4*)(blast + 16 * w + 4 * q4);
            f32x4 dec; _Pragma("unroll") for (int j = 0; j < 4; ++j) dec[j] = __expf(bl4[j]);
#pragma unroll
            for (int nb = 0; nb < 2; ++nb) {
                sacc[nb] = sacc[nb] * dec;
#pragma unroll
                for (int kk = 0; kk < 2; ++kk) sacc[nb] = MFMA16(ldfrag(KT, 72, 16 * w + l16, kk * 32 + q4 * 8), ldfrag(VT, 72, nb * 16 + l16, kk * 32 + q4 * 8), sacc[nb]);
            }
        }
        __syncthreads();
#pragma unroll
        for (int nb = 0; nb < 2; ++nb) *(LAS u32x2*)(ST + (nb * 16 + l16) * 136 + 16 * w + 4 * q4) = pk4(sacc[nb]);
    }
    float* SO = a.out + O_HGP + (size_t)(b * 4 + h) * 16384;
#pragma unroll
    for (int nb = 0; nb < 2; ++nb)
#pragma unroll
        for (int j = 0; j < 4; ++j) SO[(size_t)(16 * w + 4 * q4 + j) * 128 + eq * 32 + nb * 16 + l16] = sacc[nb][j];
    __syncthreads();
}

__device__ __forceinline__ void hgrn_sample_unit(const Ctx& C, const Args& a, int unit) {
    const int b = unit >> 2, h = unit & 3;
    const float* LF = a.out + OY_LF; const bf16_t* Q = (const bf16_t*)(a.out + OY_Q); const bf16_t* KK = (const bf16_t*)(a.out + OY_KK);
    const bf16_t* V = (const bf16_t*)(a.ws + WS_V); float* OB = (float*)(a.ws + WS_OB);
    LAS float* qs = (LAS float*)C.lds; LAS float* ks = qs + 512; LAS float* fs = ks + 512; LAS float* vs = fs + 512; LAS float* red = vs + 512;
    const int tid = fresh_tid();
    { const int j = tid >> 7, d = tid & 127; const size_t idx = (size_t)(MP + b * 4 + j) * 512 + h * 128 + d;
      qs[tid] = bf2f(Q[idx]); ks[tid] = bf2f(KK[idx]); fs[tid] = __expf(LF[idx]); vs[tid] = bf2f(V[idx]); }
    const int e = (tid & 31) * 4, dg = tid >> 5, d0 = dg * 8;
    const float* S0 = a.in[I_SHG] + (size_t)(b * 4 + h) * 16384;
    f32x4 S[8];
#pragma unroll
    for (int i = 0; i < 8; ++i) S[i] = *(const f32x4*)(S0 + (size_t)(d0 + i) * 128 + e);
    __syncthreads();
#pragma unroll
    for (int j = 0; j < 4; ++j) {
        const f32x4 v4 = *(const LAS f32x4*)(vs + j * 128 + e); f32x4 po = (f32x4){0.f, 0.f, 0.f, 0.f};
#pragma unroll
        for (int i = 0; i < 8; ++i) { const float f = fs[j * 128 + d0 + i], k = ks[j * 128 + d0 + i], q = qs[j * 128 + d0 + i]; S[i] = S[i] * f + v4 * k; po += S[i] * q; }
        *(LAS f32x4*)(red + (j * 16 + dg) * 128 + e) = po;
    }
    __syncthreads();
    { const int j = tid >> 7, ee = tid & 127; float s = 0.f;
#pragma unroll
      for (int g = 0; g < 16; ++g) s += red[(j * 16 + g) * 128 + ee];
      OB[(size_t)(MP + b * 4 + j) * 512 + h * 128 + ee] = s; }
    float* SO = a.out + O_HGS + (size_t)(b * 4 + h) * 16384;
#pragma unroll
    for (int i = 0; i < 8; ++i) *(f32x4*)(SO + (size_t)(d0 + i) * 128 + e) = S[i];
    __syncthreads();
}

template <int PARTS> __device__ __forceinline__ void attn_rows(const LAS float* Kf, const LAS float* Vf, const bf16_t* QC, bf16_t* YC, int r0, int Lq, int h, int tl) {
    const int qi = tl / PARTS, part = tl % PARTS; const int qrow = r0 + (qi < Lq ? qi : Lq - 1);
    f32x4 q[16], o[16];
#pragma unroll
    for (int j = 0; j < 8; ++j) { const u32x4 w = *(const u32x4*)(QC + (size_t)qrow * 256 + h * 64 + j * 8);
        q[2 * j] = (f32x4){bflo(w.x), bfhi(w.x), bflo(w.y), bfhi(w.y)}; q[2 * j + 1] = (f32x4){bflo(w.z), bfhi(w.z), bflo(w.w), bfhi(w.w)}; }
#pragma unroll
    for (int j = 0; j < 16; ++j) o[j] = (f32x4){0.f, 0.f, 0.f, 0.f};
    float m = -3.0e38f, l = 0.f;
#pragma unroll 1
    for (int kk = 0; kk < 256 / PARTS; ++kk) {
        const LAS float* kp = Kf + (kk * PARTS + part) * 68; const LAS float* vp = Vf + (kk * PARTS + part) * 68;
        f32x4 acc = (f32x4){0.f, 0.f, 0.f, 0.f};
#pragma unroll
        for (int j = 0; j < 16; ++j) acc += q[j] * *(const LAS f32x4*)(kp + 4 * j);
        const float s = (acc[0] + acc[1]) + (acc[2] + acc[3]);
        const float mn = fmaxf(m, s), sc = __expf(m - mn), p = __expf(s - mn);
        l = l * sc + p; m = mn;
#pragma unroll
        for (int j = 0; j < 16; ++j) o[j] = o[j] * sc + *(const LAS f32x4*)(vp + 4 * j) * p;
    }
#pragma unroll
    for (int off = 1; off < PARTS; off <<= 1) {
        const float m2 = __shfl_xor(m, off), l2 = __shfl_xor(l, off); const float mn = fmaxf(m, m2), a1 = __expf(m - mn), a2 = __expf(m2 - mn);
        l = l * a1 + l2 * a2; m = mn;
#pragma unroll
        for (int j = 0; j < 16; ++j) { f32x4 o2; o2[0] = __shfl_xor(o[j][0], off); o2[1] = __shfl_xor(o[j][1], off); o2[2] = __shfl_xor(o[j][2], off); o2[3] = __shfl_xor(o[j][3], off); o[j] = o[j] * a1 + o2 * a2; }
    }
    if (part == 0 && qi < Lq) { const float inv = 1.0f / l; bf16_t* dst = YC + (size_t)(r0 + qi) * 1024 + 768 + h * 64;
#pragma unroll
        for (int j = 0; j < 16; ++j) *(u32x2*)(dst + 4 * j) = pk4(o[j] * inv); }
}
__device__ __forceinline__ void attn_unit_mfma(const Ctx& C, const Args& a, int unit) {
    int b, h, r0, Lq; const float *Ks, *Vs;
    if (unit < 512) { b = unit >> 6; h = (unit >> 4) & 3; r0 = b * SEQ + (unit & 15) * 128; Lq = 128; Ks = a.out + O_MEMK + (size_t)b * 65536; Vs = a.out + O_MEMV + (size_t)b * 65536; }
    else { const int u2 = unit - 512; b = u2 >> 2; h = u2 & 3; r0 = MP + b * 4; Lq = 4; Ks = a.in[I_CK] + (size_t)b * 65536; Vs = a.in[I_CV] + (size_t)b * 65536; }
    const bf16_t* QC = (const bf16_t*)(a.ws + WS_QC); bf16_t* YC = (bf16_t*)(a.ws + WS_XH);
    LAS bf16_t* Kl = (LAS bf16_t*)C.lds;
    LAS bf16_t* VT = Kl + 256 * 72;
    LAS bf16_t* Pl = VT + 64 * 264 + C.wave * (16 * 264);
    const int tid = fresh_tid(), lane = tid & 63, w = C.wave, l16 = lane & 15, q4 = lane >> 4;
#pragma unroll
    for (int i = 0; i < 8; ++i) { const int idx = tid + i * 512, key = idx >> 4, d4 = (idx & 15) * 4;
        const f32x4 kf = *(const f32x4*)(Ks + (size_t)key * 256 + h * 64 + d4), vf = *(const f32x4*)(Vs + (size_t)key * 256 + h * 64 + d4);
        *(LAS u32x2*)(Kl + key * 72 + d4) = pk4(kf);
        const u32x2 vp = pk4(vf);
        VT[(d4 + 0) * 264 + key] = (bf16_t)(vp.x & 0xffffu); VT[(d4 + 1) * 264 + key] = (bf16_t)(vp.x >> 16);
        VT[(d4 + 2) * 264 + key] = (bf16_t)(vp.y & 0xffffu); VT[(d4 + 3) * 264 + key] = (bf16_t)(vp.y >> 16); }
    __syncthreads();
    {
        const int qi = w * 16 + l16, qrow = r0 + (qi < Lq ? qi : Lq - 1);
        bf16x8 qf[2];
#pragma unroll
        for (int kk = 0; kk < 2; ++kk) qf[kk] = *(const bf16x8*)(QC + (size_t)qrow * 256 + h * 64 + kk * 32 + q4 * 8);
        f32x4 s[16]; float mx = -3.0e38f;
#pragma unroll
        for (int mb = 0; mb < 16; ++mb) { f32x4 acc = (f32x4){0.f, 0.f, 0.f, 0.f};
#pragma unroll
            for (int kk = 0; kk < 2; ++kk) acc = MFMA16(ldfrag(Kl, 72, mb * 16 + l16, kk * 32 + q4 * 8), qf[kk], acc);
            s[mb] = acc; mx = fmaxf(mx, fmaxf(fmaxf(acc[0], acc[1]), fmaxf(acc[2], acc[3]))); }
        mx = fmaxf(mx, __shfl_xor(mx, 16)); mx = fmaxf(mx, __shfl_xor(mx, 32));
        float sum = 0.f;
#pragma unroll
        for (int mb = 0; mb < 16; ++mb) { f32x4 p; _Pragma("unroll") for (int j = 0; j < 4; ++j) { p[j] = __expf(s[mb][j] - mx); sum += p[j]; }
            *(LAS u32x2*)(Pl + l16 * 264 + mb * 16 + 4 * q4) = pk4(p); }
        sum += __shfl_xor(sum, 16); sum += __shfl_xor(sum, 32);
        const float inv = 1.0f / sum;
        __syncthreads();
#pragma unroll
        for (int db = 0; db < 4; ++db) { f32x4 acc = (f32x4){0.f, 0.f, 0.f, 0.f};
#pragma unroll
            for (int kb = 0; kb < 8; ++kb) acc = MFMA16(ldfrag(VT, 264, db * 16 + l16, kb * 32 + q4 * 8), ldfrag(Pl, 264, l16, kb * 32 + q4 * 8), acc);
            if (qi < Lq) *(u32x2*)(YC + (size_t)(r0 + qi) * 1024 + 768 + h * 64 + db * 16 + 4 * q4) = pk4(acc * inv); }
    }
    __syncthreads();
}

__device__ __forceinline__ void attn_unit(const Ctx& C, const Args& a, int unit) {
    int b, h, r0; const float *Ks, *Vs;
    if (unit < 512) { b = unit >> 6; h = (unit >> 4) & 3; r0 = b * SEQ + (unit & 15) * 128; Ks = a.out + O_MEMK + (size_t)b * 65536; Vs = a.out + O_MEMV + (size_t)b * 65536; }
    else { const int u2 = unit - 512; b = u2 >> 2; h = u2 & 3; r0 = MP + b * 4; Ks = a.in[I_CK] + (size_t)b * 65536; Vs = a.in[I_CV] + (size_t)b * 65536; }
    const bf16_t* QC = (const bf16_t*)(a.ws + WS_QC); bf16_t* YC = (bf16_t*)(a.ws + WS_XH);
    LAS float* Kf = (LAS float*)C.lds;
    LAS float* Vf = Kf + 256 * 68;
    const int tid = fresh_tid();
#pragma unroll
    for (int i = 0; i < 8; ++i) { const int idx = tid + i * 512, key = idx >> 4, d4 = (idx & 15) * 4;
        *(LAS f32x4*)(Kf + key * 68 + d4) = *(const f32x4*)(Ks + (size_t)key * 256 + h * 64 + d4);
        *(LAS f32x4*)(Vf + key * 68 + d4) = *(const f32x4*)(Vs + (size_t)key * 256 + h * 64 + d4); }
    __syncthreads();
    if (unit < 512) attn_rows<4>(Kf, Vf, QC, YC, r0, 128, h, tid);
    else if (C.wave == 0) attn_rows<16>(Kf, Vf, QC, YC, r0, 4, h, tid);
    __syncthreads();
}

template <int WN> __device__ __forceinline__ void pool_rows_prompt(const float* UA, bf16_t* YC, float* outp, int R0, int c) {
    const int t0 = R0 & (SEQ - 1);
    float v[47];
#pragma unroll
    for (int i = 0; i < 15; ++i) v[i] = t0 > 0 ? UA[(size_t)(R0 - 15 + i) * 256 + c] : 0.f;
#pragma unroll
    for (int i = 0; i < 32; ++i) v[15 + i] = UA[(size_t)(R0 + i) * 256 + c];
    float S = 0.f;
#pragma unroll
    for (int k = 1; k < WN; ++k) S += v[15 - k];
#pragma unroll
    for (int i = 0; i < 32; ++i) {
        S += v[15 + i];
        const int t = t0 + i; const float cnt = (float)(t + 1 < WN ? t + 1 : WN);
        YC[(size_t)(R0 + i) * 1024 + c] = f2bf(S / cnt - v[15 + i]);
        if (t >= SEQ - 15) outp[((size_t)((R0 + i) >> 11) * 15 + (t - (SEQ - 15))) * 256 + c] = v[15 + i];
        S -= v[15 + i - (WN - 1)];
    }
}
__device__ __forceinline__ void pool_unit(const Ctx& C, const Args& a, int unit) {
    const float* UA = (const float*)(a.ws + WS_UA); bf16_t* YC = (bf16_t*)(a.ws + WS_XH);
    const int tid = fresh_tid(); const int c = tid & 255, half = tid >> 8, g = c >> 6, wn = 2 << g;
    if (unit < MP / 64) {
        const int R0 = unit * 64 + half * 32; float* outp = a.out + O_POOLP;
        if (g == 0) pool_rows_prompt<2>(UA, YC, outp, R0, c); else if (g == 1) pool_rows_prompt<4>(UA, YC, outp, R0, c);
        else if (g == 2) pool_rows_prompt<8>(UA, YC, outp, R0, c); else pool_rows_prompt<16>(UA, YC, outp, R0, c);
        return;
    }
    {
        const int row = MP + (unit - MP / 64) * 2 + half;
        const float u = UA[(size_t)row * 256 + c]; float s = u;
        const int j = row & 3, bb = (row - MP) >> 2; const float cnt = (float)wn;
        const float* sp = a.in[I_SPOOL] + (size_t)bb * 15 * 256 + c;
#pragma unroll
        for (int k = 1; k < 16; ++k) if (k < wn) { const int p = j - k; s += p >= 0 ? UA[(size_t)(row - k) * 256 + c] : sp[(size_t)(15 + p) * 256]; }
        float* po = a.out + O_POOLS + (size_t)bb * 15 * 256 + c;
        po[(size_t)(11 + j) * 256] = u;
        if (j == 0) for (int k = 0; k < 11; ++k) po[(size_t)k * 256] = sp[(size_t)(k + 4) * 256];
        YC[(size_t)row * 1024 + c] = f2bf(s / cnt - u);
    }
}

__device__ __forceinline__ int fetch_unit(const Ctx& C, unsigned* ctr, volatile LAS int* slot) {
    __syncthreads();
    if (fresh_tid() == 0) *slot = (int)atomicAdd(ctr, 1u);
    __syncthreads();
    return *slot;
}

__device__ __forceinline__ void ln_row(const float* src, bf16_t* oh, float* of, const float* g, const float* bta, int lane, const float* part = nullptr, int nparts = 0, const float* rx = nullptr, const bf16_t* rh = nullptr) {
    f32x4 v[4]; float s = 0.f;
#pragma unroll
    for (int j = 0; j < 4; ++j) {
        if (part) { v[j] = rx ? *(const f32x4*)(rx + 4 * lane + 256 * j) * DN_ALPHA : unpk4(*(const u32x2*)(rh + 4 * lane + 256 * j)) * DN_ALPHA;
            for (int p = 0; p < nparts; ++p) v[j] += *(const f32x4*)(part + (size_t)p * (512 * 1024) + 4 * lane + 256 * j); }
        else v[j] = *(const f32x4*)(src + 4 * lane + 256 * j);
        s += (v[j][0] + v[j][1]) + (v[j][2] + v[j][3]); }
    const float mean = wave_sum(s) * (1.f / 1024.f); float s2 = 0.f;
#pragma unroll
    for (int j = 0; j < 4; ++j) { v[j] = v[j] - mean; s2 += (v[j][0] * v[j][0] + v[j][1] * v[j][1]) + (v[j][2] * v[j][2] + v[j][3] * v[j][3]); }
    const float rstd = 1.f / sqrtf(wave_sum(s2) * (1.f / 1024.f) + LN_EPS);
#pragma unroll
    for (int j = 0; j < 4; ++j) { const f32x4 gg = *(const f32x4*)(g + 4 * lane + 256 * j), bb = *(const f32x4*)(bta + 4 * lane + 256 * j); const f32x4 o = v[j] * rstd * gg + bb;
        if (oh) *(u32x2*)(oh + 4 * lane + 256 * j) = pk4(o); else *(f32x4*)(of + 4 * lane + 256 * j) = o; }
}

#define XB_TMO      128
#define XB_XCNT(j)  (256  + 64 * (j))
#define XB_XSUB(j)  (1280 + 64 * (j))
#define XB_XGEN(j)  (2304 + 64 * (j))
#define XB_TOP      3328
#define XB_TOPGEN   3392
#define XCD_BAR_WORDS 3456
#define XB_SPIN_CAP (1u << 18)

__device__ __forceinline__ unsigned xb_ld(unsigned* p)              { return __hip_atomic_load(p, __ATOMIC_RELAXED, __HIP_MEMORY_SCOPE_AGENT); }
__device__ __forceinline__ unsigned xb_add(unsigned* p, unsigned v) { return __hip_atomic_fetch_add(p, v, __ATOMIC_RELAXED, __HIP_MEMORY_SCOPE_AGENT); }
__device__ __forceinline__ unsigned xb_xcc_id() { return (unsigned)__builtin_amdgcn_s_getreg((3 << 11) | 20) & 0xFu; }
#define XB_SPIN(cond, bar) do { unsigned _sp = 0; while (cond) { __builtin_amdgcn_s_sleep(1); \
    if ((++_sp & 255u) == 0u) { if (xb_ld(&(bar)[XB_TMO])) break; if (_sp > XB_SPIN_CAP) { atomicAdd(&(bar)[XB_TMO], 1u); break; } } } } while (0)

struct XcdBarrier {
    unsigned* bar; unsigned x;
    volatile LAS unsigned* st;
};

__device__ __forceinline__ XcdBarrier xcd_barrier_post(unsigned* bar, volatile LAS unsigned* st) {
    XcdBarrier b; b.bar = bar; b.x = xb_xcc_id(); b.st = st;
    if (threadIdx.x == 0) (void)xb_add(&bar[XB_XCNT(b.x)], 1u);
    return b;
}
__device__ __forceinline__ void xcd_barrier_complete(unsigned* bar, unsigned x, unsigned& nloc, unsigned& nx) {
    const unsigned G = gridDim.x * gridDim.y * gridDim.z;
    unsigned sum, cnt, mine, sp = 0u;
    for (;;) {
        sum = 0u; cnt = 0u; mine = 0u;
#pragma unroll
        for (unsigned j = 0; j < 16; ++j) { const unsigned c = xb_ld(&bar[XB_XCNT(j)]); sum += c; cnt += (c > 0u) ? 1u : 0u; mine = (j == x) ? c : mine; }
        if (sum == G) break;
        __builtin_amdgcn_s_sleep(1);
        if ((++sp & 255u) == 0u) { if (xb_ld(&bar[XB_TMO])) break; if (sp > XB_SPIN_CAP) { atomicAdd(&bar[XB_TMO], 1u); break; } }
    }
    nloc = mine > 0u ? mine : 1u; nx = cnt > 0u ? cnt : 1u;
}

__device__ __forceinline__ void xcd_barrier(const XcdBarrier& b) {
    asm volatile("s_waitcnt vmcnt(0)" ::: "memory");
    __syncthreads();
    if (threadIdx.x == 0) {
        unsigned* bar = b.bar;
        __builtin_amdgcn_s_waitcnt(0);
        unsigned nloc = b.st[0], nx = b.st[1];
        if (nloc == 0u) { xcd_barrier_complete(bar, b.x, nloc, nx); b.st[0] = nloc; b.st[1] = nx; }
        const unsigned old = xb_add(&bar[XB_XSUB(b.x)], 1u);
        const unsigned gen = old / nloc;
        if (old + 1u == (gen + 1u) * nloc) {
            __builtin_amdgcn_fence(__ATOMIC_RELEASE, "agent");
            asm volatile("s_waitcnt vmcnt(0)" ::: "memory");
            const unsigned og = xb_add(&bar[XB_TOP], 1u);
            const unsigned tg = og / nx;
            if (og + 1u == (tg + 1u) * nx) xb_add(&bar[XB_TOPGEN], 1u);
            else XB_SPIN(xb_ld(&bar[XB_TOPGEN]) == tg, bar);
            __builtin_amdgcn_fence(__ATOMIC_ACQUIRE, "agent");
            xb_add(&bar[XB_XGEN(b.x)], 1u);
            asm volatile("s_waitcnt vmcnt(0)" ::: "memory");
        } else {
            XB_SPIN(xb_ld(&bar[XB_XGEN(b.x)]) == gen, bar);
            __builtin_amdgcn_fence(__ATOMIC_ACQUIRE, "agent");
            asm volatile("s_waitcnt vmcnt(0)" ::: "memory");
        }
    }
    __syncthreads();
}

__device__ __forceinline__ constexpr int in_size_of(int k) {
    return k == 0 ? 16777216 : k == 1 ? 524288 : k == 2 ? 491520 : k == 3 ? 8388608 : k == 4 ? 720896 : k == 5 ? 8388608 : k == 6 ? 8388608 : k == 7 ? 2097152 : k == 8 ? 1024 : k == 9 ? 5767168 :
           k == 10 ? 16384 : k == 11 ? 256 : k == 12 ? 512 : k == 13 ? 262144 : k == 14 ? 262144 : k == 15 ? 262144 : k == 16 ? 524288 : k == 17 ? 262144 : k == 18 ? 1048576 : k == 19 ? 1024 : k == 20 ? 1024 :
           k == 21 ? 2883584 : k == 22 ? 2883584 : k == 23 ? 8448 : k == 24 ? 2816 : k == 25 ? 2883584 : 1024;
}
__device__ __forceinline__ float gelu_as(float v) {
    const float av = fabsf(v), t = __builtin_amdgcn_rcpf(av * 0.2316418882f + 1.0f);
    float q = t * 0.5307027145f + (-0.7265760135f); q = q * t + 0.7107068705f; q = q * t + (-0.142248368f); q = q * t + 0.127414796f; q = q * t;
    const float e = __builtin_amdgcn_exp2f((v * v) * (-0.72134752044f));
    const float mm = v * (q * e);
    return v < 0.f ? mm : v - mm;
}
__global__ void __launch_bounds__(512, 2) fwd_kernel(Args a) {
    extern __shared__ __attribute__((aligned(16))) unsigned char lds_raw[];
    cg::grid_group grid = cg::this_grid();
    Ctx C; C.lds = (LAS unsigned char*)lds_raw; C.wave = __builtin_amdgcn_readfirstlane((int)threadIdx.x >> 6); C.G = gridDim.x; C.bid = blockIdx.x;
    unsigned char* ws = a.ws;
    unsigned* ctl = (unsigned*)(ws + WS_CTL);
    const int gw = C.bid * 8 + C.wave, NGW = C.G * 8;
    const size_t GT = (size_t)C.G * 512;
    float* YR = a.out + O_Y;
    volatile LAS unsigned* bst = (volatile LAS unsigned*)(C.lds + LDS_BYTES - 32);
    if (threadIdx.x < 2) bst[threadIdx.x] = 0u;
    __syncthreads();
    XcdBarrier bar = xcd_barrier_post(ctl + 1024, bst);
    {
        const unsigned xcc = xb_xcc_id() & 7u; volatile LAS int* rk = (volatile LAS int*)(C.lds + LDS_BYTES - 16);
        if (threadIdx.x == 0) rk[0] = (int)atomicAdd(ctl + 600 + xcc, 1u);
        __syncthreads(); C.xcd = (int)xcc; C.rank = __builtin_amdgcn_readfirstlane(rk[0]);
    }
    grid.sync();
#define GRID_BAR() xcd_barrier(bar)
    C.nloc = __builtin_amdgcn_readfirstlane((int)__hip_atomic_load(ctl + 600 + C.xcd, __ATOMIC_RELAXED, __HIP_MEMORY_SCOPE_AGENT));

    for (int rr_ = 0; rr_ <= ((a.pad >> 0) & 1); ++rr_) {
    p0_prep(C, a);
    GRID_BAR();
    }
    if (a.stop == 0) return;

    for (int rr_ = 0; rr_ <= ((a.pad >> 1) & 1); ++rr_) {
    {
        pg8::Gemm g{(const bf16_t*)(ws + WS_XH), (const bf16_t*)(ws + WS_WIN), MT, INC, 1024, 1024}; pg8::StaticOrder S; S.init(MT, INC, C.G, C.bid);
        pg8::EpiIn E{(float*)(ws + WS_UA), (bf16_t*)(a.out + OY_Q), a.out + OY_LF, (bf16_t*)(a.out + OY_KK), (bf16_t*)(ws + WS_V), (bf16_t*)(ws + WS_G), (bf16_t*)(ws + WS_QC), (bf16_t*)(ws + WS_GATE), (const float*)(ws + WS_LBT)};
        pg8::gemm_phase<pg8::EpiIn, pg8::StaticOrder, true, true>(C.lds, g, S, E);
        pg8::Gemm g2{(const bf16_t*)(ws + WS_MEMH), (const bf16_t*)(ws + WS_WMEM), 2048, 512, 1024, 1024}; pg8::XcdOrder S2; S2.init(2048, 512, C.G, C.bid); S2.own(C.xcd, C.rank, C.nloc); S2.r = (S2.r + 2) % S2.nloc;
        pg8::EpiMem E2{a.out + O_MEMK, a.out + O_MEMV};
        pg8::gemm_phase<pg8::EpiMem, pg8::XcdOrder, true, true>(C.lds, g2, S2, E2);
    }
    GRID_BAR();
    }
    if (a.stop == 1) {
        const float* UA = (const float*)(ws + WS_UA); const float* LF = a.out + OY_LF; const bf16_t* Q = (const bf16_t*)(a.out + OY_Q); const bf16_t* KK = (const bf16_t*)(a.out + OY_KK);
        const bf16_t* V = (const bf16_t*)(ws + WS_V); const bf16_t* G = (const bf16_t*)(ws + WS_G); const bf16_t* QC = (const bf16_t*)(ws + WS_QC); const bf16_t* GT_ = (const bf16_t*)(ws + WS_GATE);
        float* D = a.out + O_HGS; const size_t gt = (size_t)C.bid * 512 + fresh_tid();
        for (size_t i = gt; i < (size_t)MT * 256; i += GT) { const size_t r = i >> 8; const int c = (int)(i & 255);
            float s = UA[r * 256 + c] + bf2f(QC[r * 256 + c]);
            for (int k = c; k < 512; k += 256) s += LF[r * 512 + k] + bf2f(Q[r * 512 + k]) + bf2f(KK[r * 512 + k]) + bf2f(V[r * 512 + k]) + bf2f(G[r * 512 + k]);
            for (int k = c; k < 3072; k += 256) s += bf2f(GT_[r * 3072 + k]);
            D[i] = s; }
        return;
    }

    for (int rr_ = 0; rr_ <= ((a.pad >> 2) & 1); ++rr_) {
    {
        const int ox = C.xcd, orank = C.rank;
        if (orank < 16) { for (int r2_ = 0; r2_ <= ((a.pad >> 9) & 1); ++r2_) hgrn_prompt_unit(C, a, ox * 16 + orank); }
        volatile LAS int* slot = (volatile LAS int*)(C.lds + LDS_BYTES - 64);
        for (;;) {
            const int u = fetch_unit(C, ctl + 64 + 64 * rr_, slot);
            if (u >= 512 + 512 + 512 + 512) break;
            if (u < 512) attn_unit(C, a, 512 + u);
            else if (u < 1024) hgrn_sample_unit(C, a, u - 512);
            else if (u < 1536) attn_unit_mfma(C, a, u - 1024);
            else pool_unit(C, a, u - 1536);
        }
    }
    GRID_BAR();
    }
    if (a.stop == 2) {
        const float* OB = (const float*)(ws + WS_OB); const bf16_t* YC = (const bf16_t*)(ws + WS_XH); const size_t gt = (size_t)C.bid * 512 + fresh_tid();
        for (size_t i = gt; i < (size_t)MT * 1024; i += GT) { const size_t r = i >> 10; const int c = (int)(i & 1023);
            YR[i] = c < 512 ? OB[r * 512 + c] : (c < 768 ? bf2f(YC[r * 1024 + c - 512]) : bf2f(YC[r * 1024 + c])); }
        return;
    }

    {
        const float* OB = (const float*)(ws + WS_OB); const bf16_t* G = (const bf16_t*)(ws + WS_G); bf16_t* YC = (bf16_t*)(ws + WS_XH); const float* gn = a.in[I_HGG];
        const int lane = fresh_tid() & 63; const int ox = C.xcd, orank = C.rank, onloc = C.nloc, onr = own_nrows(ox);
        const f32x4 g0 = *(const f32x4*)(gn + 8 * lane), g1 = *(const f32x4*)(gn + 8 * lane + 4);
#pragma unroll 2
        for (int l = orank * 8 + C.wave; l < onr; l += onloc * 8) {
            const int row = own_row(ox, l); const size_t idx = (size_t)row * 512 + 8 * lane;
            const f32x4 o0 = *(const f32x4*)(OB + idx), o1 = *(const f32x4*)(OB + idx + 4); const u32x4 gr = *(const u32x4*)(G + idx);
            float ss = (o0[0] * o0[0] + o0[1] * o0[1]) + (o0[2] * o0[2] + o0[3] * o0[3]) + (o1[0] * o1[0] + o1[1] * o1[1]) + (o1[2] * o1[2] + o1[3] * o1[3]);
#pragma unroll
            for (int off = 1; off < 16; off <<= 1) ss += __shfl_xor(ss, off);
            const float r = __builtin_amdgcn_rsqf(ss * (1.f / 128.f) + RMS_EPS);
            u32x4 w; w.x = cvt_pk(o0[0] * r * g0[0] * bflo(gr.x), o0[1] * r * g0[1] * bfhi(gr.x)); w.y = cvt_pk(o0[2] * r * g0[2] * bflo(gr.y), o0[3] * r * g0[3] * bfhi(gr.y));
            w.z = cvt_pk(o1[0] * r * g1[0] * bflo(gr.z), o1[1] * r * g1[1] * bfhi(gr.z)); w.w = cvt_pk(o1[2] * r * g1[2] * bflo(gr.w), o1[3] * r * g1[3] * bfhi(gr.w));
            *(u32x4*)(YC + (size_t)row * 1024 + 256 + 8 * lane) = w;
        }
    }
    GRID_BAR();
    if (a.stop == 3) {
        const bf16_t* YC = (const bf16_t*)(ws + WS_XH); const size_t gt = (size_t)C.bid * 512 + fresh_tid();
        for (size_t i = gt; i < (size_t)MT * 1024; i += GT) YR[i] = bf2f(YC[i]);
        return;
    }

    for (int rr_ = 0; rr_ <= ((a.pad >> 3) & 1); ++rr_) {
    {
        const bf16_t* YC = (const bf16_t*)(ws + WS_XH); const bf16_t* WB = (const bf16_t*)(ws + WS_WBR); const bf16_t* GATE = (const bf16_t*)(ws + WS_GATE);
        pg8::BranchOrder S; S.init(C.G, C.bid);
        pg8::Gemm g{YC, WB, MT, 1024, 1024, 1024}; pg8::EpiBr E{GATE, (bf16_t*)(ws + WS_OB)};
        pg8::gemm_phase<pg8::EpiBr, pg8::BranchOrder, true, true>(C.lds, g, S, E);
    }
    GRID_BAR();
    }
    if (a.stop == 4) return;

    for (int rr_ = 0; rr_ <= ((a.pad >> 4) & 1); ++rr_) {
    {
        pg8::Gemm g{(const bf16_t*)(ws + WS_OB), (const bf16_t*)(ws + WS_WOUT), MT, 1024, 1024, 1024}; pg8::SplitOrder S; S.init(1024, C.G, C.bid, 4, 1);
        pg8::EpiOut E{a.in[I_XP], a.in[I_XS], YR, (float*)(ws + WS_GATE)};
        pg8::gemm_phase<pg8::EpiOut, pg8::SplitOrder, true, true>(C.lds, g, S, E);
    }
    GRID_BAR();
    }
    if (a.stop == 5) return;

    { const int lane = fresh_tid() & 63; const int ox = C.xcd, orank = C.rank, onloc = C.nloc, onr = own_nrows(ox);
      for (int l = orank * 8 + C.wave; l < onr; l += onloc * 8) { const int row = own_row(ox, l);
          if (row < MP) ln_row(YR + (size_t)row * 1024, (bf16_t*)(ws + WS_XH) + (size_t)row * 1024, nullptr, a.in[I_LN1G], a.in[I_LN1B], lane);
          else ln_row(nullptr, (bf16_t*)(ws + WS_XH) + (size_t)row * 1024, nullptr, a.in[I_LN1G], a.in[I_LN1B], lane, (const float*)(ws + WS_GATE) + (size_t)(row - MP) * 1024, 12, a.in[I_XS] + (size_t)(row - MP) * 1024, nullptr); } }
    GRID_BAR();
    if (a.stop == 6) {
        const bf16_t* YC = (const bf16_t*)(ws + WS_XH); const size_t gt = (size_t)C.bid * 512 + fresh_tid();
        for (size_t i = gt; i < (size_t)MT * 1024; i += GT) YR[i] = bf2f(YC[i]);
        return;
    }

    for (int rr_ = 0; rr_ <= ((a.pad >> 6) & 1); ++rr_) {
    {
        pg8::Gemm g{(const bf16_t*)(ws + WS_XH), (const bf16_t*)(ws + WS_WGU), MT, 2 * DFF, 1024, 1024}; pg8::StaticOrder S; S.init(MT, 2 * DFF, C.G, C.bid);
        pg8::EpiFfn1 E{(bf16_t*)(ws + WS_A16), (bf16_t*)(ws + WS_U16), a.out + O_CONVP, a.out + O_CONVS};
        pg8::gemm_phase<pg8::EpiFfn1, pg8::StaticOrder, true, true>(C.lds, g, S, E);
    }
    GRID_BAR();
    }
    if (a.stop == 7) {
        const bf16_t* A_ = (const bf16_t*)(ws + WS_A16); const bf16_t* U_ = (const bf16_t*)(ws + WS_U16); const size_t gt = (size_t)C.bid * 512 + fresh_tid();
        for (size_t i = gt; i < (size_t)MT * 1024; i += GT) { const size_t r = i >> 10; const int c = (int)(i & 1023); float s = 0.f; for (int k = c; k < DFF; k += 1024) s += bf2f(A_[r * DFF + k]) + 2.0f * bf2f(U_[r * DFF + k]); YR[i] = s; }
        return;
    }

    {
        const bf16_t* A16 = (const bf16_t*)(ws + WS_A16); bf16_t* U16 = (bf16_t*)(ws + WS_U16);
        const float* cw = a.in[I_CONVW]; const float* cb = a.in[I_CONVB]; const float* sc = a.in[I_SCONV];
        const int tid = fresh_tid(); const int ox = C.xcd, orank = C.rank, onloc = C.nloc;
        if (tid < DFF / 8) {
            const int c8 = tid * 8;
            float w0[8], w1[8], w2[8], bb_[8];
#pragma unroll
            for (int e = 0; e < 8; ++e) { w0[e] = cw[c8 + e]; w1[e] = cw[DFF + c8 + e]; w2[e] = cw[2 * DFF + c8 + e]; bb_[e] = cb[c8 + e]; }
            const int nchunk = 32 + (ox < 2 ? 64 : 0);
            for (int ch = orank; ch < nchunk; ch += onloc) {
                int R0, nr; float x0[8], x1[8];
                if (ch < 32) { R0 = ox * 2048 + ch * 64; nr = 64;
                    if (ch > 0) { const u32x4 p1 = *(const u32x4*)(A16 + (size_t)(R0 - 1) * DFF + c8), p0 = *(const u32x4*)(A16 + (size_t)(R0 - 2) * DFF + c8);
                        _Pragma("unroll") for (int e = 0; e < 4; ++e) { x1[2 * e] = bflo(p1[e]); x1[2 * e + 1] = bfhi(p1[e]); x0[2 * e] = bflo(p0[e]); x0[2 * e + 1] = bfhi(p0[e]); } }
                    else { _Pragma("unroll") for (int e = 0; e < 8; ++e) { x0[e] = 0.f; x1[e] = 0.f; } }
                } else { const int sb_ = ox * 64 + (ch - 32); R0 = MP + sb_ * 4; nr = 4; const float* sp = sc + (size_t)sb_ * 2 * DFF + c8;
                    _Pragma("unroll") for (int e = 0; e < 8; ++e) { x0[e] = sp[e]; x1[e] = sp[DFF + e]; } }
#pragma unroll 4
                for (int i = 0; i < nr; ++i) {
                    const size_t off = (size_t)(R0 + i) * DFF + c8;
                    const u32x4 a2 = *(const u32x4*)(A16 + off); const u32x4 uu = *(const u32x4*)(U16 + off);
                    float r[8];
#pragma unroll
                    for (int e = 0; e < 8; ++e) {
                        const float x2 = (e & 1) ? bfhi(a2[e >> 1]) : bflo(a2[e >> 1]); const float uv = (e & 1) ? bfhi(uu[e >> 1]) : bflo(uu[e >> 1]);
                        const float cv = bb_[e] + w0[e] * x0[e] + w1[e] * x1[e] + w2[e] * x2;
                        r[e] = gelu_as(cv) * uv; x0[e] = x1[e]; x1[e] = x2;
                    }
                    u32x4 o; o.x = cvt_pk(r[0], r[1]); o.y = cvt_pk(r[2], r[3]); o.z = cvt_pk(r[4], r[5]); o.w = cvt_pk(r[6], r[7]);
                    *(u32x4*)(U16 + off) = o;
                }
            }
        }
    }
    GRID_BAR();
    if (a.stop == 8) {
        const bf16_t* U_ = (const bf16_t*)(ws + WS_U16); const size_t gt = (size_t)C.bid * 512 + fresh_tid();
        for (size_t i = gt; i < (size_t)MT * 1024; i += GT) { const size_t r = i >> 10; const int c = (int)(i & 1023); float s = 0.f; for (int k = c; k < DFF; k += 1024) s += bf2f(U_[r * DFF + k]); YR[i] = s; }
        return;
    }

    for (int rr_ = 0; rr_ <= ((a.pad >> 8) & 1); ++rr_) {
    {
        pg8::Gemm g{(const bf16_t*)(ws + WS_U16), (const bf16_t*)(ws + WS_WDOWN), MT, 1024, DFF, DFF}; pg8::SplitOrder S; S.init(DFF, C.G, C.bid, 11);
        pg8::EpiFfn2 E{(const bf16_t*)(ws + WS_XH), YR, (float*)(ws + WS_A16)};
        pg8::gemm_phase<pg8::EpiFfn2, pg8::SplitOrder, true, true>(C.lds, g, S, E);
    }
    GRID_BAR();
    }
    if (a.stop == 9) return;

    { const int lane = fresh_tid() & 63; const int ox = C.xcd, orank = C.rank, onloc = C.nloc, onr = own_nrows(ox);
      for (int l = orank * 8 + C.wave; l < onr; l += onloc * 8) { const int row = own_row(ox, l);
          if (row < MP) ln_row(YR + (size_t)row * 1024, nullptr, YR + (size_t)row * 1024, a.in[I_LN2G], a.in[I_LN2B], lane);
          else ln_row(nullptr, nullptr, YR + (size_t)row * 1024, a.in[I_LN2G], a.in[I_LN2B], lane, (const float*)(ws + WS_A16) + (size_t)(row - MP) * 1024, 11, nullptr, (const bf16_t*)(ws + WS_XH) + (size_t)row * 1024); } }
}

extern "C" void kernel_launch(void* const* d_in, const int* in_sizes, int n_in, void* d_out, int out_size, void* d_ws, size_t ws_size, hipStream_t stream) {
    static int grid = 0;
    if (grid == 0) {
        if (n_in != 28 || (size_t)out_size != O_END || ws_size < WS_END) { fprintf(stderr, "kernel_launch: unexpected problem: n_in %d out %d ws %zu\n", n_in, out_size, ws_size); grid = -1; return; }
        int dev = 0, cus = 0, per_cu = 0;
        (void)hipGetDevice(&dev);
        (void)hipDeviceGetAttribute(&cus, hipDeviceAttributeMultiprocessorCount, dev);
        (void)hipFuncSetAttribute((const void*)fwd_kernel, hipFuncAttributeMaxDynamicSharedMemorySize, LDS_BYTES);
        (void)hipOccupancyMaxActiveBlocksPerMultiprocessor(&per_cu, (const void*)fwd_kernel, 512, LDS_BYTES);
        if (per_cu < 1) per_cu = 1;
        grid = cus * per_cu;
        fprintf(stderr, "kernel_launch: grid %d (cus %d x %d) ws %zu\n", grid, cus, per_cu, ws_size);
    }
    if (grid < 0) return;
    (void)hipMemsetAsync((char*)d_ws + WS_CTL, 0, CTL_BYTES, stream);
    Args a{};
    for (int i = 0; i < 28; ++i) a.in[i] = (const float*)d_in[i];
    a.out = (float*)d_out; a.ws = (unsigned char*)d_ws; a.stop = STOP_RT; a.pad = REP_MASK;
    void* args[] = {&a};
    hipError_t e = hipLaunchCooperativeKernel((const void*)fwd_kernel, dim3(grid), dim3(512), args, LDS_BYTES, stream);
    if (e != hipSuccess) fprintf(stderr, "kernel_launch: cooperative launch failed: %s (grid %d)\n", hipGetErrorString(e), grid);
}
```
